# Optimizing an MI355X kernel written in HIP

```python
import jax, jax.numpy as jnp
from jax import lax
import numpy as np

D_MODEL = 1024
BATCH = 16
SEQ = 2048
DEPTH = 2

MEM_LEN = 256
HEAD_DIM = 64
N_SELF_HEADS = 12
N_KV_HEADS_SWA = 3
N_CROSS_HEADS = 4
SWA_WINDOW = 128
BLOCK = 128
ROPE_THETA = 10000.0
D_FF = 3584
N_EXPERTS = 8
TOP_K = 2
RMS_EPS = 1e-6
N_MIXERS = 2
MAX_START = 4096

SELF_W = N_SELF_HEADS * HEAD_DIM
KV_W_SWA = N_KV_HEADS_SWA * HEAD_DIM
CROSS_W = N_CROSS_HEADS * HEAD_DIM
IN_W_SWA = SELF_W + 2 * KV_W_SWA + CROSS_W
IN_W_SB = 3 * SELF_W + CROSS_W
MIX_W = SELF_W + CROSS_W

kernel_name = "hybrid_swa_stickbreak_memx_moe"


def rms_norm(x, g):
    xf = x.astype(jnp.float32)
    var = jnp.mean(xf * xf, axis=-1, keepdims=True)
    return (xf * lax.rsqrt(var + RMS_EPS) * g.astype(jnp.float32)).astype(x.dtype)


def rope(x, positions):
    inv_freq = ROPE_THETA ** (-jnp.arange(0, HEAD_DIM, 2, dtype=jnp.float32) / HEAD_DIM)
    ang = positions.astype(jnp.float32)[..., None] * inv_freq
    cos = jnp.cos(ang)[:, :, None, :]
    sin = jnp.sin(ang)[:, :, None, :]
    xf = x.astype(jnp.float32)
    x1, x2 = jnp.split(xf, 2, axis=-1)
    out = jnp.concatenate([x1 * cos - x2 * sin, x2 * cos + x1 * sin], axis=-1)
    return out.astype(x.dtype)


def swa_sink_attention(q, k, v, sinks):
    B, S, Hq, hd = q.shape
    Hkv = k.shape[2]
    G = Hq // Hkv
    nb = S // BLOCK
    scale = hd ** -0.5
    qb = q.reshape(B, nb, BLOCK, Hkv, G, hd)

    def band(t):
        tb = t.reshape(B, nb, BLOCK, Hkv, hd)
        prev = jnp.pad(tb[:, :-1], ((0, 0), (1, 0), (0, 0), (0, 0), (0, 0)))
        return jnp.concatenate([prev, tb], axis=2)

    kband, vband = band(k), band(v)
    scores = jnp.einsum('bnqhgd,bnkhd->bnhgqk', qb, kband,
                        preferred_element_type=jnp.float32) * scale
    qi = jnp.arange(BLOCK)[:, None]
    kj = jnp.arange(2 * BLOCK)[None, :]
    diff = qi + BLOCK - kj
    in_win = (diff >= 0) & (diff < SWA_WINDOW)
    blk = jnp.arange(nb)[:, None]
    key_ok = (blk * BLOCK + kj - BLOCK) >= 0
    mask = in_win[None, :, :] & key_ok[:, None, :]
    scores = jnp.where(mask[None, :, None, None], scores, -jnp.inf)
    sink = sinks.astype(jnp.float32).reshape(Hkv, G)[None, None, :, :, None, None]
    m = jnp.maximum(jnp.max(scores, axis=-1, keepdims=True), sink)
    p = jnp.exp(scores - m)
    denom = jnp.sum(p, axis=-1, keepdims=True) + jnp.exp(sink - m)
    probs = (p / denom).astype(v.dtype)
    out = jnp.einsum('bnhgqk,bnkhd->bnqhgd', probs, vband)
    return out.reshape(B, S, Hq * hd)


def stick_breaking_attention(q, k, v):
    B, S, H, hd = q.shape
    nb = S // BLOCK
    scale = hd ** -0.5
    qb = q.reshape(B, nb, BLOCK, H, hd).transpose(1, 0, 3, 2, 4)
    kt = k.transpose(0, 2, 1, 3)
    vt = v.transpose(0, 2, 1, 3)
    s_idx = jnp.arange(S)

    def one_block(args):
        q_blk, blk = args
        z = jnp.einsum('bhqd,bhkd->bhqk', q_blk, kt,
                       preferred_element_type=jnp.float32) * scale
        t_idx = blk * BLOCK + jnp.arange(BLOCK)
        causal = s_idx[None, :] < t_idx[:, None]
        log_1m = jnp.where(causal, jax.nn.log_sigmoid(-z), 0.0)
        later = lax.cumsum(log_1m, axis=3, reverse=True) - log_1m
        w = jnp.where(causal, jnp.exp(jax.nn.log_sigmoid(z) + later), 0.0)
        return jnp.einsum('bhqk,bhkd->bhqd', w.astype(vt.dtype), vt)

    out = lax.map(one_block, (qb, jnp.arange(nb)))
    return out.transpose(1, 0, 3, 2, 4).reshape(B, S, H * hd)


def memory_cross_attention(qc, mem_n, w_mem_kv):
    B, S, _ = qc.shape
    kv = mem_n @ w_mem_kv
    km, vm = jnp.split(kv, 2, axis=-1)
    qh = qc.reshape(B, S, N_CROSS_HEADS, HEAD_DIM)
    km = km.reshape(B, MEM_LEN, N_CROSS_HEADS, HEAD_DIM)
    vm = vm.reshape(B, MEM_LEN, N_CROSS_HEADS, HEAD_DIM)
    scores = jnp.einsum('bshd,bmhd->bhsm', qh, km,
                        preferred_element_type=jnp.float32) * (HEAD_DIM ** -0.5)
    probs = jax.nn.softmax(scores, axis=-1).astype(vm.dtype)
    out = jnp.einsum('bhsm,bmhd->bshd', probs, vm)
    return out.reshape(B, S, CROSS_W)


def token_mixing(h, mem, positions, mixer, p):
    B, S, _ = h.shape
    xn = rms_norm(h, p['attn_pre_g'])
    proj = xn @ p['w_in']
    if mixer == 0:
        q, k, v, qc = jnp.split(proj, [SELF_W, SELF_W + KV_W_SWA, SELF_W + 2 * KV_W_SWA], axis=-1)
        q = rope(q.reshape(B, S, N_SELF_HEADS, HEAD_DIM), positions)
        k = rope(k.reshape(B, S, N_KV_HEADS_SWA, HEAD_DIM), positions)
        v = v.reshape(B, S, N_KV_HEADS_SWA, HEAD_DIM)
        self_out = swa_sink_attention(q, k, v, p['sinks'])
    else:
        q, k, v, qc = jnp.split(proj, [SELF_W, 2 * SELF_W, 3 * SELF_W], axis=-1)
        q = q.reshape(B, S, N_SELF_HEADS, HEAD_DIM)
        k = k.reshape(B, S, N_SELF_HEADS, HEAD_DIM)
        v = v.reshape(B, S, N_SELF_HEADS, HEAD_DIM)
        self_out = stick_breaking_attention(q, k, v)
    mem_n = rms_norm(mem, p['mem_g'])
    cross_out = memory_cross_attention(qc, mem_n, p['w_mem_kv'])
    mixed = jnp.concatenate([self_out, cross_out], axis=-1) @ p['w_out']
    return h + rms_norm(mixed, p['attn_post_g'])


def swiglu(x, w_gate, w_up, w_down):
    return (jax.nn.silu(x @ w_gate) * (x @ w_up)) @ w_down


def moe_swiglu(x, w_router, w_gate, w_up, w_down):
    B, S, D = x.shape
    xt = x.reshape(B * S, D)
    logits = jnp.matmul(xt, w_router, preferred_element_type=jnp.float32)
    top_vals, top_idx = lax.top_k(logits, TOP_K)
    top_w = jax.nn.softmax(top_vals, axis=-1)
    gates = jnp.sum(jax.nn.one_hot(top_idx, N_EXPERTS, dtype=jnp.float32) * top_w[..., None], axis=1)
    out = jnp.zeros((B * S, D), jnp.float32)
    for e in range(N_EXPERTS):
        y = swiglu(xt, w_gate[e], w_up[e], w_down[e]).astype(jnp.float32)
        out = out + gates[:, e:e + 1] * y
    return out.astype(x.dtype).reshape(B, S, D)


def channel_mixing(h, layer_idx, p):
    xn = rms_norm(h, p['ffn_pre_g'])
    if layer_idx % 2 == 0:
        y = swiglu(xn, p['w_gate'], p['w_up'], p['w_down'])
    else:
        y = moe_swiglu(xn, p['w_router'], p['w_gate'], p['w_up'], p['w_down'])
    return h + rms_norm(y, p['ffn_post_g'])


def setup_inputs(seed: int = 0) -> dict:
    key = jax.random.key(seed)
    ks = jax.random.split(key, 32)
    f32 = jnp.float32

    def nrm(k, shape, fan_in):
        return jax.random.normal(k, shape, f32) * (fan_in ** -0.5)

    def gain(k):
        return 1.0 + 0.05 * jax.random.normal(k, (D_MODEL,), f32)

    x = jax.random.normal(ks[0], (BATCH, SEQ, D_MODEL), f32)
    mem = jax.random.normal(ks[1], (BATCH, MEM_LEN, D_MODEL), f32)
    start = jax.random.randint(ks[2], (BATCH, 1), 0, MAX_START, dtype=jnp.int32)
    positions = start + jnp.arange(SEQ, dtype=jnp.int32)[None, :]
    return {
        "x": x,
        "mem": mem,
        "positions": positions,
        "l0_attn_pre_g": gain(ks[3]),
        "l0_mem_g": gain(ks[4]),
        "l0_w_in": nrm(ks[5], (D_MODEL, IN_W_SWA), D_MODEL),
        "l0_w_mem_kv": nrm(ks[6], (D_MODEL, 2 * CROSS_W), D_MODEL),
        "l0_sinks": 0.5 * jax.random.normal(ks[7], (N_SELF_HEADS,), f32),
        "l0_w_out": nrm(ks[8], (MIX_W, D_MODEL), MIX_W),
        "l0_attn_post_g": gain(ks[9]),
        "l0_ffn_pre_g": gain(ks[10]),
        "l0_w_gate": nrm(ks[11], (D_MODEL, D_FF), D_MODEL),
        "l0_w_up": nrm(ks[12], (D_MODEL, D_FF), D_MODEL),
        "l0_w_down": nrm(ks[13], (D_FF, D_MODEL), D_FF),
        "l0_ffn_post_g": gain(ks[14]),
        "l1_attn_pre_g": gain(ks[15]),
        "l1_mem_g": gain(ks[16]),
        "l1_w_in": nrm(ks[17], (D_MODEL, IN_W_SB), D_MODEL),
        "l1_w_mem_kv": nrm(ks[18], (D_MODEL, 2 * CROSS_W), D_MODEL),
        "l1_w_out": nrm(ks[19], (MIX_W, D_MODEL), MIX_W),
        "l1_attn_post_g": gain(ks[20]),
        "l1_ffn_pre_g": gain(ks[21]),
        "l1_w_router": nrm(ks[22], (D_MODEL, N_EXPERTS), D_MODEL),
        "l1_w_gate": nrm(ks[23], (N_EXPERTS, D_MODEL, D_FF), D_MODEL),
        "l1_w_up": nrm(ks[24], (N_EXPERTS, D_MODEL, D_FF), D_MODEL),
        "l1_w_down": nrm(ks[25], (N_EXPERTS, D_FF, D_MODEL), D_FF),
        "l1_ffn_post_g": gain(ks[26]),
    }


def reference(x, mem, positions,
              l0_attn_pre_g, l0_mem_g, l0_w_in, l0_w_mem_kv, l0_sinks, l0_w_out, l0_attn_post_g,
              l0_ffn_pre_g, l0_w_gate, l0_w_up, l0_w_down, l0_ffn_post_g,
              l1_attn_pre_g, l1_mem_g, l1_w_in, l1_w_mem_kv, l1_w_out, l1_attn_post_g,
              l1_ffn_pre_g, l1_w_router, l1_w_gate, l1_w_up, l1_w_down, l1_ffn_post_g):
    layers = [
        dict(attn_pre_g=l0_attn_pre_g, mem_g=l0_mem_g, w_in=l0_w_in, w_mem_kv=l0_w_mem_kv,
             sinks=l0_sinks, w_out=l0_w_out, attn_post_g=l0_attn_post_g,
             ffn_pre_g=l0_ffn_pre_g, w_gate=l0_w_gate, w_up=l0_w_up, w_down=l0_w_down,
             ffn_post_g=l0_ffn_post_g),
        dict(attn_pre_g=l1_attn_pre_g, mem_g=l1_mem_g, w_in=l1_w_in, w_mem_kv=l1_w_mem_kv,
             w_out=l1_w_out, attn_post_g=l1_attn_post_g,
             ffn_pre_g=l1_ffn_pre_g, w_router=l1_w_router, w_gate=l1_w_gate, w_up=l1_w_up,
             w_down=l1_w_down, ffn_post_g=l1_ffn_post_g),
    ]
    h = x
    for i in range(DEPTH):
        p = layers[i]
        h = token_mixing(h, mem, positions, i % N_MIXERS, p)
        h = channel_mixing(h, i, p)
    return h
```

```cpp
#include <hip/hip_runtime.h>
#include <cstdio>
#include <cstdint>

#ifndef MOE_FP8
#define MOE_FP8 1
#endif
#ifndef FFN0_MODE
#define FFN0_MODE 2
#endif
#ifndef DOWN0_FP8
#define DOWN0_FP8 0
#endif
#ifndef PROJ1_I8
#define PROJ1_I8 1
#endif
#ifndef PROJ0_I8
#define PROJ0_I8 0
#endif
#ifndef MK_PER_PHASE
#define MK_PER_PHASE 0
#endif

namespace pg8 {
#define PG8_LAS __attribute__((address_space(3)))
typedef unsigned short bf16_t;
typedef short bf16x8 __attribute__((ext_vector_type(8)));
typedef float f32x4 __attribute__((ext_vector_type(4)));
typedef unsigned u32x4 __attribute__((ext_vector_type(4)));
constexpr int BM = 256, BK = 64, HALF = 128, HTB = HALF * BK * 2  , STAGE_BYTES = 8 * HTB, NXCD = 8, WGM = 8;

__host__ __device__ __forceinline__ int lds_byte(int r, int c) { const int st = (r >> 4) * 2 + (c >> 5), rr = r & 15, cc = c & 31, ob = rr * 64 + cc * 2; return st * 1024 + (ob ^ (((ob >> 9) & 1) << 5)); }
__host__ __device__ __forceinline__ void stage_rc(int b, int& R, int& C) { const int st = b / 1024, sb = b % 1024, swz = sb ^ (((sb >> 9) & 1) << 5); R = (st >> 1) * 16 + swz / 64; C = (st & 1) * 32 + (swz % 64) / 2; }
__host__ __device__ __forceinline__ int perm32(int rho) { const int n = rho >> 4, i = rho & 15; return 8 * (i >> 2) + 4 * n + (i & 3); }

struct Unit { int pm, pn, om, on; };
struct Gemm { const bf16_t* A; const bf16_t* Bt; int M, N, K; };

struct StaticOrder {
    int nM, nN, nwg, G, c;
    __host__ __device__ void init(int M, int N, int G_, int c_) { nM = M / BM; nN = N / BM; nwg = nM * nN; G = G_; c = c_; }
    __host__ __device__ bool tile(int i, int& tm, int& tn) const {
        const long L = (long)i * G + c; if (L >= nwg) return false;
        int wgid = (int)L; { const int q = nwg / NXCD, r = nwg % NXCD, xcd = wgid % NXCD, off = wgid / NXCD; wgid = (xcd < r ? xcd * (q + 1) : r * (q + 1) + (xcd - r) * q) + off; }
        const int nig = WGM * nN, gid = wgid / nig, fm = gid * WGM, gsz = (nM - fm) < WGM ? (nM - fm) : WGM;
        tm = fm + ((wgid % nig) % gsz); tn = (wgid % nig) / gsz; return true;
    }
    __host__ __device__ bool next(int i, Unit& u) const { int tm, tn; if (!tile(i, tm, tn)) return false; u.pm = tm; u.pn = tn; u.om = tm; u.on = tn; return true; }
    __device__ __forceinline__ void a_ready(const Unit&) const {}
    __device__ __forceinline__ void done(const Unit&) const {}
};
struct Proj0Order {
    StaticOrder so; int nmain;
    __device__ void init(int G_, int c_) { so.init(32768, 1536, G_, c_); nmain = so.nwg; }
    __device__ bool next(int i, Unit& u) const {
        const long L = (long)i * so.G + so.c;
        if (L < nmain) return so.next(i, u);
        const int x = (int)(L - nmain); if (x >= 64) return false;
        const int w = x >> 5, y = x & 31;
        u.pm = 128 + 16 * w + (y >> 1); u.pn = 6 + 2 * w + (y & 1); u.om = u.pm; u.on = u.pn; return true;
    }
    __device__ __forceinline__ void a_ready(const Unit&) const {}
    __device__ __forceinline__ void done(const Unit&) const {}
};
template <bool A_LOCAL> struct MoeOrder {
    StaticOrder so; int t0, a_add; const PG8_LAS unsigned char* tab;
    __device__ void init(int nM, int nN, int t0_, const PG8_LAS unsigned char* tab_, int G_, int c_, int a_add_ = 0) { so.init(nM * BM, nN * BM, G_, c_); t0 = t0_; tab = tab_; a_add = a_add_; }
    __device__ bool next(int i, Unit& u) const {
        int tm, tn; if (so.nwg <= 0 || !so.tile(i, tm, tn)) return false;
        const int gt = t0 + tm, e = (int)tab[gt];
        u.pm = (A_LOCAL ? tm : gt) + a_add; u.pn = e * so.nN + tn; u.om = A_LOCAL ? gt : tm; u.on = tn; return true;
    }
    __device__ __forceinline__ void a_ready(const Unit&) const {}
    __device__ __forceinline__ void done(const Unit&) const {}
};

__device__ __forceinline__ unsigned cvt_pk_bf16(float lo, float hi) { unsigned r; asm volatile("v_cvt_pk_bf16_f32 %0, %1, %2" : "=v"(r) : "v"(lo), "v"(hi)); return r; }
__device__ __forceinline__ u32x4 pack8(const f32x4 a, const f32x4 b) { u32x4 w; w.x = cvt_pk_bf16(a[0], a[1]); w.y = cvt_pk_bf16(a[2], a[3]); w.z = cvt_pk_bf16(b[0], b[1]); w.w = cvt_pk_bf16(b[2], b[3]); return w; }

struct EpiPlain {
    static constexpr bool PERM = true, AFTER_DRAIN = false;
    bf16_t* O; int ldc; float ascale;
    __device__ __forceinline__ void operator()(const f32x4 (&acc)[2][2][4][2], const Unit& u, int wr, int wc, int fr, int fq) const {
        const int row0 = u.om * BM + wr * 64 + fr, col0 = u.on * BM + wc * 32 + 8 * fq;
#pragma unroll
        for (int ai = 0; ai < 2; ++ai)
#pragma unroll
            for (int m = 0; m < 4; ++m) { bf16_t* rowp = O + (size_t)(row0 + ai * HALF + m * 16) * ldc + col0;
#pragma unroll
                for (int bj = 0; bj < 2; ++bj) *(u32x4*)(rowp + bj * HALF) = pack8(acc[ai][bj][m][0] * ascale, acc[ai][bj][m][1] * ascale); }
    }
};
struct EpiProj0 {
    static constexpr bool PERM = true, AFTER_DRAIN = false;
    bf16_t* P; bf16_t* KV; const float* rope;
    const float* rowscale; const float* colscale;
    __device__ __forceinline__ void operator()(const f32x4 (&acc)[2][2][4][2], const Unit& u, int wr, int wc, int fr, int fq) const {
        bf16_t* base; int ldc, rowt, colt; bool do_rope;
        if (u.pm < 128) { base = P; ldc = 1536; rowt = u.pm; colt = u.pn; do_rope = u.pn < 4; }
        else { const int w = (u.pm >= 144) ? 1 : 0; base = KV + (size_t)w * 4096 * 512; ldc = 512; rowt = u.pm - 128 - 16 * w; colt = u.pn - 6 - 2 * w; do_rope = false; }
        const int row0 = rowt * BM + wr * 64 + fr, col0 = colt * BM + wc * 32 + 8 * fq, dl = 16 * (wc & 1) + 4 * fq;
        f32x4 csc[2][2];
        if (PROJ0_I8) {
#pragma unroll
            for (int bj = 0; bj < 2; ++bj) { csc[bj][0] = *(const f32x4*)(colscale + u.pn * BM + wc * 32 + 8 * fq + bj * HALF); csc[bj][1] = *(const f32x4*)(colscale + u.pn * BM + wc * 32 + 8 * fq + bj * HALF + 4); } }
#pragma unroll
        for (int ai = 0; ai < 2; ++ai)
#pragma unroll
            for (int m = 0; m < 4; ++m) { const int r = row0 + ai * HALF + m * 16; bf16_t* rowp = base + (size_t)r * ldc + col0;
                float rsc = 1.f; if (PROJ0_I8) rsc = rowscale[u.pm * BM + wr * 64 + fr + ai * HALF + m * 16];
                f32x4 cs = (f32x4){1.f, 1.f, 1.f, 1.f}, sn = (f32x4){0.f, 0.f, 0.f, 0.f};
                if (do_rope) { cs = *(const f32x4*)(rope + (size_t)r * 64 + dl); sn = *(const f32x4*)(rope + (size_t)r * 64 + 32 + dl); }
#pragma unroll
                for (int bj = 0; bj < 2; ++bj) { f32x4 v0 = acc[ai][bj][m][0], v1 = acc[ai][bj][m][1];
                    if (PROJ0_I8) { typedef int i32x4 __attribute__((ext_vector_type(4))); const i32x4 a0 = __builtin_bit_cast(i32x4, v0), a1 = __builtin_bit_cast(i32x4, v1);
                        v0 = (f32x4){(float)a0[0], (float)a0[1], (float)a0[2], (float)a0[3]} * (csc[bj][0] * rsc); v1 = (f32x4){(float)a1[0], (float)a1[1], (float)a1[2], (float)a1[3]} * (csc[bj][1] * rsc); }
                    const f32x4 o0 = v0 * cs - v1 * sn, o1 = v1 * cs + v0 * sn;
                    *(u32x4*)(rowp + bj * HALF) = pack8(o0, o1); } }
    }
};
__device__ __forceinline__ float silu_mul(float g, float u) { return g * __builtin_amdgcn_rcpf(1.0f + __builtin_amdgcn_exp2f(-1.4426950408889634f * g)) * u; }
typedef float f32x2 __attribute__((ext_vector_type(2)));
__device__ __forceinline__ f32x2 sig_mul2(f32x2 tg, f32x2 pu) { f32x2 e; e.x = __builtin_amdgcn_exp2f(tg.x); e.y = __builtin_amdgcn_exp2f(tg.y); const f32x2 d = e + 1.0f; f32x2 r; r.x = __builtin_amdgcn_rcpf(d.x); r.y = __builtin_amdgcn_rcpf(d.y); return pu * r; }
struct EpiSwiglu {
    static constexpr bool PERM = true, AFTER_DRAIN = false;
    bf16_t* H;
    __device__ __forceinline__ void operator()(const f32x4 (&acc)[2][2][4][2], const Unit& u, int wr, int wc, int fr, int fq) const {
        const int row0 = u.om * BM + wr * 64 + fr, col0 = u.on * HALF + wc * 32 + 8 * fq;
#pragma unroll
        for (int ai = 0; ai < 2; ++ai)
#pragma unroll
            for (int m = 0; m < 4; ++m) { bf16_t* rowp = H + (size_t)(row0 + ai * HALF + m * 16) * 3584 + col0;
                f32x4 h0, h1;
#pragma unroll
                for (int j = 0; j < 4; ++j) { h0[j] = silu_mul(acc[ai][0][m][0][j], acc[ai][1][m][0][j]); h1[j] = silu_mul(acc[ai][0][m][1][j], acc[ai][1][m][1][j]); }
                *(u32x4*)rowp = pack8(h0, h1); }
    }
};
__device__ __forceinline__ unsigned pk4_fp8(float a, float b, float c, float d) {
    a = __builtin_amdgcn_fmed3f(a, -448.f, 448.f); b = __builtin_amdgcn_fmed3f(b, -448.f, 448.f); c = __builtin_amdgcn_fmed3f(c, -448.f, 448.f); d = __builtin_amdgcn_fmed3f(d, -448.f, 448.f);
    int w = 0; w = __builtin_amdgcn_cvt_pk_fp8_f32(a, b, w, false); w = __builtin_amdgcn_cvt_pk_fp8_f32(c, d, w, true); return (unsigned)w; }
struct EpiSwiglu8 {
    static constexpr bool PERM = true, AFTER_DRAIN = false;
    unsigned char* H; float ascale, hscale;
    __device__ __forceinline__ void operator()(const f32x4 (&acc)[2][2][4][2], const Unit& u, int wr, int wc, int fr, int fq) const {
        typedef unsigned u32x2 __attribute__((ext_vector_type(2)));
        const int row0 = u.om * BM + wr * 64 + fr, col0 = u.on * HALF + wc * 32 + 8 * fq;
#pragma unroll
        for (int ai = 0; ai < 2; ++ai)
#pragma unroll
            for (int m = 0; m < 4; ++m) { unsigned char* rowp = H + (size_t)(row0 + ai * HALF + m * 16) * 3584 + col0;
                const float c1 = -1.4426950408889634f * ascale, c2 = ascale * ascale * hscale;
                const f32x4 g0 = acc[ai][0][m][0], g1 = acc[ai][0][m][1], u0 = acc[ai][1][m][0], u1 = acc[ai][1][m][1];
                const f32x2 a = sig_mul2((f32x2){g0[0], g0[1]} * c1, (f32x2){g0[0], g0[1]} * (f32x2){u0[0], u0[1]} * c2), b = sig_mul2((f32x2){g0[2], g0[3]} * c1, (f32x2){g0[2], g0[3]} * (f32x2){u0[2], u0[3]} * c2);
                const f32x2 c = sig_mul2((f32x2){g1[0], g1[1]} * c1, (f32x2){g1[0], g1[1]} * (f32x2){u1[0], u1[1]} * c2), d = sig_mul2((f32x2){g1[2], g1[3]} * c1, (f32x2){g1[2], g1[3]} * (f32x2){u1[2], u1[3]} * c2);
                const f32x4 h0 = (f32x4){a.x, a.y, b.x, b.y}, h1 = (f32x4){c.x, c.y, d.x, d.y};
                u32x2 w; w.x = pk4_fp8(h0[0], h0[1], h0[2], h0[3]); w.y = pk4_fp8(h1[0], h1[1], h1[2], h1[3]); *(u32x2*)rowp = w; }
    }
};
struct EpiSwigluI8 {
    static constexpr bool PERM = true, AFTER_DRAIN = false;
    bf16_t* H; const float* rowscale; const float* cs_gate; const float* cs_up; float hscale;
    __device__ __forceinline__ void operator()(const f32x4 (&acc)[2][2][4][2], const Unit& u, int wr, int wc, int fr, int fq) const {
        typedef int i32x4 __attribute__((ext_vector_type(4)));
        const int row0 = u.om * BM + wr * 64 + fr, col0 = u.on * HALF + wc * 32 + 8 * fq;
        const f32x4 g0 = *(const f32x4*)(cs_gate + col0), g1 = *(const f32x4*)(cs_gate + col0 + 4), gu0 = g0 * *(const f32x4*)(cs_up + col0), gu1 = g1 * *(const f32x4*)(cs_up + col0 + 4);
#pragma unroll
        for (int ai = 0; ai < 2; ++ai)
#pragma unroll
            for (int m = 0; m < 4; ++m) { const int r = row0 + ai * HALF + m * 16; const float rs = rowscale[r]; bf16_t* rowp = H + (size_t)r * 3584 + col0;
                const i32x4 ag0 = __builtin_bit_cast(i32x4, acc[ai][0][m][0]), ag1 = __builtin_bit_cast(i32x4, acc[ai][0][m][1]), au0 = __builtin_bit_cast(i32x4, acc[ai][1][m][0]), au1 = __builtin_bit_cast(i32x4, acc[ai][1][m][1]);
                const float rs1 = -1.4426950408889634f * rs, rs2 = rs * rs;
                f32x4 h0, h1;
#pragma unroll
                for (int j = 0; j < 4; j += 2) {
                    const f32x2 a = sig_mul2((f32x2){(float)ag0[j], (float)ag0[j + 1]} * ((f32x2){g0[j], g0[j + 1]} * rs1), (f32x2){(float)ag0[j], (float)ag0[j + 1]} * (f32x2){(float)au0[j], (float)au0[j + 1]} * ((f32x2){gu0[j], gu0[j + 1]} * rs2));
                    const f32x2 b = sig_mul2((f32x2){(float)ag1[j], (float)ag1[j + 1]} * ((f32x2){g1[j], g1[j + 1]} * rs1), (f32x2){(float)ag1[j], (float)ag1[j + 1]} * (f32x2){(float)au1[j], (float)au1[j + 1]} * ((f32x2){gu1[j], gu1[j + 1]} * rs2));
                    h0[j] = a.x; h0[j + 1] = a.y; h1[j] = b.x; h1[j + 1] = b.y; }
                if (DOWN0_FP8) { typedef unsigned u32x2 __attribute__((ext_vector_type(2))); u32x2 w; w.x = pk4_fp8(h0[0] * hscale, h0[1] * hscale, h0[2] * hscale, h0[3] * hscale); w.y = pk4_fp8(h1[0] * hscale, h1[1] * hscale, h1[2] * hscale, h1[3] * hscale);
                    *(u32x2*)((unsigned char*)H + (size_t)r * 3584 + col0) = w; }
                else *(u32x4*)rowp = pack8(h0, h1); }
    }
};
struct EpiPlainI8 {
    static constexpr bool PERM = true, AFTER_DRAIN = false;
    bf16_t* O; int ldc; const float* rowscale; const float* colscale;
    __device__ __forceinline__ void operator()(const f32x4 (&acc)[2][2][4][2], const Unit& u, int wr, int wc, int fr, int fq) const {
        typedef int i32x4 __attribute__((ext_vector_type(4)));
        const int row0 = u.om * BM + wr * 64 + fr, col0 = u.on * BM + wc * 32 + 8 * fq;
        f32x4 cs[2][2];
#pragma unroll
        for (int bj = 0; bj < 2; ++bj) { cs[bj][0] = *(const f32x4*)(colscale + col0 + bj * HALF); cs[bj][1] = *(const f32x4*)(colscale + col0 + bj * HALF + 4); }
#pragma unroll
        for (int ai = 0; ai < 2; ++ai)
#pragma unroll
            for (int m = 0; m < 4; ++m) { const int r = row0 + ai * HALF + m * 16; const float rs = rowscale[r]; bf16_t* rowp = O + (size_t)r * ldc + col0;
#pragma unroll
                for (int bj = 0; bj < 2; ++bj) { const i32x4 a0 = __builtin_bit_cast(i32x4, acc[ai][bj][m][0]), a1 = __builtin_bit_cast(i32x4, acc[ai][bj][m][1]);
                    const f32x4 v0 = (f32x4){(float)a0[0], (float)a0[1], (float)a0[2], (float)a0[3]} * (cs[bj][0] * rs), v1 = (f32x4){(float)a1[0], (float)a1[1], (float)a1[2], (float)a1[3]} * (cs[bj][1] * rs);
                    *(u32x4*)(rowp + bj * HALF) = pack8(v0, v1); } }
    }
};
struct EpiMoeDown {
    static constexpr bool PERM = true, AFTER_DRAIN = false;
    bf16_t* Y; const float* sw; float ascale;
    __device__ __forceinline__ void operator()(const f32x4 (&acc)[2][2][4][2], const Unit& u, int wr, int wc, int fr, int fq) const {
        const int row0 = u.om * BM + wr * 64 + fr, col0 = u.on * BM + wc * 32 + 8 * fq;
#pragma unroll
        for (int ai = 0; ai < 2; ++ai)
#pragma unroll
            for (int m = 0; m < 4; ++m) { const int r = row0 + ai * HALF + m * 16; const float s = sw[r] * ascale; bf16_t* rowp = Y + (size_t)r * 1024 + col0;
#pragma unroll
                for (int bj = 0; bj < 2; ++bj) *(u32x4*)(rowp + bj * HALF) = pack8(acc[ai][bj][m][0] * s, acc[ai][bj][m][1] * s); }
    }
};

typedef int i32x4 __attribute__((ext_vector_type(4)));
typedef int i32x8 __attribute__((ext_vector_type(8)));
__device__ __forceinline__ i32x8 cat8(bf16x8 a, bf16x8 b) { const i32x4 x = __builtin_bit_cast(i32x4, a), y = __builtin_bit_cast(i32x4, b); return __builtin_shufflevector(x, y, 0, 1, 2, 3, 4, 5, 6, 7); }
template <class Epi, class Sched, bool ALIGN_EPI = false, bool SP2 = false, int MODE = 0>
__device__ __forceinline__ void gemm_phase(PG8_LAS unsigned char* lds, const Gemm g, const Sched& S, const Epi& E, int wid) {
    constexpr bool FP8 = (MODE == 1);
    int lane; asm volatile("v_mbcnt_lo_u32_b32 %0, -1, 0\n\tv_mbcnt_hi_u32_b32 %0, -1, %0" : "=v"(lane));
    const int tid = wid * 64 + lane, wr = wid >> 2, wc = wid & 3, fr = lane & 15, fq = lane >> 4;
    const int K = g.K, nt = K / BK;
    unsigned voffA[2], voffB[2];
#pragma unroll
    for (int i = 0; i < 2; ++i) { int R, C; stage_rc(tid * 16 + i * 8192, R, C); static_assert(Epi::PERM, "weight copies are stored with each 32-row group already in perm32 order"); const int Rb = R;
        voffA[i] = (unsigned)(R * K + C) * 2u; voffB[i] = (unsigned)(Rb * K + C) * 2u; }
    const unsigned kstep = (unsigned)(BK * 2);
    const unsigned hstep = (unsigned)HALF * K * 2;
    const unsigned tstep = 2 * hstep;
    const __amdgpu_buffer_rsrc_t rs_voffA = __builtin_amdgcn_make_buffer_rsrc((void*)g.A, 0, 0x7fffffff, 0x00020000), rs_voffB = __builtin_amdgcn_make_buffer_rsrc((void*)g.Bt, 0, 0x7fffffff, 0x00020000);
    const unsigned ldsw = (unsigned)wid * 1024u;
    const int aoff = lds_byte(wr * 64 + fr, fq * 8), boff = lds_byte(wc * 32 + fr, fq * 8);
#define PG8_SA(b, h) (((b) * 2 + (h)) * HTB)
#define PG8_SB(b, h) ((4 + (b) * 2 + (h)) * HTB)
#define PG8_STAGE(bufoff, gbase, voff) do { _Pragma("unroll") for (int _i = 0; _i < 2; ++_i) \
        __builtin_amdgcn_raw_ptr_buffer_load_lds(rs_##voff, (PG8_LAS void*)(lds + (bufoff) + ldsw + _i * 8192), 16, (int)(voff)[_i], (int)(gbase), 0, 0); } while (0)
#define PG8_LDA(dst, b, h) do { if constexpr (FP8) { _Pragma("unroll") for (int m = 0; m < 4; ++m) { const i32x4 lo_ = *(const PG8_LAS i32x4*)(lds + PG8_SA(b, h) + aoff + m * 2048), hi_ = *(const PG8_LAS i32x4*)(lds + PG8_SA(b, h) + aoff + m * 2048 + 1024); dst##8[m] = __builtin_shufflevector(lo_, hi_, 0, 1, 2, 3, 4, 5, 6, 7); } } \
    else { _Pragma("unroll") for (int m = 0; m < 4; ++m) _Pragma("unroll") for (int k = 0; k < 2; ++k) dst[m][k] = *(const PG8_LAS bf16x8*)(lds + PG8_SA(b, h) + aoff + m * 2048 + k * 1024); } } while (0)
#define PG8_LDB(dst, b, h) do { if constexpr (FP8) { _Pragma("unroll") for (int n = 0; n < 2; ++n) { const i32x4 lo_ = *(const PG8_LAS i32x4*)(lds + PG8_SB(b, h) + boff + n * 2048), hi_ = *(const PG8_LAS i32x4*)(lds + PG8_SB(b, h) + boff + n * 2048 + 1024); dst##8[n] = __builtin_shufflevector(lo_, hi_, 0, 1, 2, 3, 4, 5, 6, 7); } } \
    else { _Pragma("unroll") for (int n = 0; n < 2; ++n) _Pragma("unroll") for (int k = 0; k < 2; ++k) dst[n][k] = *(const PG8_LAS bf16x8*)(lds + PG8_SB(b, h) + boff + n * 2048 + k * 1024); } } while (0)
#define PG8_MMA(ai, bj, At, Bt) do { __builtin_amdgcn_s_setprio(1); \
        if constexpr (FP8) { _Pragma("unroll") for (int m = 0; m < 4; ++m) _Pragma("unroll") for (int n = 0; n < 2; ++n) \
            acc[ai][bj][m][n] = __builtin_amdgcn_mfma_scale_f32_16x16x128_f8f6f4(Bt##8[n], At##8[m], acc[ai][bj][m][n], 0, 0, 0, 0x7f7f7f7f, 0, 0x7f7f7f7f); } \
        else if constexpr (MODE == 2) { _Pragma("unroll") for (int m = 0; m < 4; ++m) _Pragma("unroll") for (int n = 0; n < 2; ++n) _Pragma("unroll") for (int k = 0; k < 2; ++k) \
            acc[ai][bj][m][n] = __builtin_bit_cast(f32x4, __builtin_amdgcn_mfma_i32_16x16x64_i8(__builtin_bit_cast(i32x4, Bt[n][k]), __builtin_bit_cast(i32x4, At[m][k]), __builtin_bit_cast(i32x4, acc[ai][bj][m][n]), 0, 0, 0)); } \
        else { _Pragma("unroll") for (int m = 0; m < 4; ++m) _Pragma("unroll") for (int n = 0; n < 2; ++n) _Pragma("unroll") for (int k = 0; k < 2; ++k) \
            acc[ai][bj][m][n] = __builtin_amdgcn_mfma_f32_16x16x32_bf16(Bt[n][k], At[m][k], acc[ai][bj][m][n], 0, 0, 0); } \
        __builtin_amdgcn_s_setprio(0); } while (0)
#define PG8_WAIT_V(n) asm volatile("s_waitcnt vmcnt(" #n ")" ::: "memory")
#define PG8_WAIT_L(n) asm volatile("s_waitcnt lgkmcnt(" #n ")" ::: "memory")
#define PG8_BAR __builtin_amdgcn_s_barrier()
#define PG8_SCHED __builtin_amdgcn_sched_barrier(0)
    Unit cur, nxt; int ui = 0;
    if (!S.next(0, cur)) return;
    f32x4 acc[2][2][4][2];
#pragma unroll
    for (int a = 0; a < 2; ++a)
#pragma unroll
        for (int b = 0; b < 2; ++b)
#pragma unroll
            for (int m = 0; m < 4; ++m)
#pragma unroll
                for (int n = 0; n < 2; ++n) acc[a][b][m][n] = (f32x4){0.f, 0.f, 0.f, 0.f};
    bf16x8 At[4][2], B0[2][2], B1[2][2]; i32x8 At8[4], B08[2], B18[2];
    unsigned cA = (unsigned)cur.pm * tstep, cB = (unsigned)cur.pn * tstep;
    S.a_ready(cur);
    if constexpr (SP2) {
        PG8_STAGE(PG8_SB(0, 0), cB, voffB); PG8_STAGE(PG8_SB(0, 1), cB + hstep, voffB); PG8_STAGE(PG8_SA(0, 0), cA, voffA); PG8_STAGE(PG8_SA(0, 1), cA + hstep, voffA);
        if (wr == 1) PG8_BAR;
        PG8_WAIT_V(2); PG8_BAR;
        PG8_STAGE(PG8_SB(1, 0), cB + kstep, voffB); PG8_STAGE(PG8_SA(1, 0), cA + kstep, voffA); PG8_STAGE(PG8_SB(1, 1), cB + hstep + kstep, voffB);
        PG8_WAIT_V(6); PG8_BAR;
    } else {
        PG8_STAGE(PG8_SB(0, 0), cB, voffB); PG8_STAGE(PG8_SA(0, 0), cA, voffA); PG8_STAGE(PG8_SB(0, 1), cB + hstep, voffB); PG8_STAGE(PG8_SA(0, 1), cA + hstep, voffA);
        if (wr == 1) PG8_BAR;
        PG8_WAIT_V(4); PG8_BAR;
        PG8_STAGE(PG8_SB(1, 0), cB + kstep, voffB); PG8_STAGE(PG8_SA(1, 0), cA + kstep, voffA); PG8_STAGE(PG8_SB(1, 1), cB + hstep + kstep, voffB);
        PG8_WAIT_V(6); PG8_BAR;
    }
    for (;;) {
        const bool has_next = S.next(ui + 1, nxt);
        const unsigned nA = has_next ? (unsigned)nxt.pm * tstep : cA, nB = has_next ? (unsigned)nxt.pn * tstep : cB;
#pragma unroll 1
        for (int t = 0; t < nt; t += 2) {
            const bool last = (t == nt - 2);
            const unsigned a1 = cA + (unsigned)(t + 1) * kstep;
            const unsigned a2 = last ? nA : cA + (unsigned)(t + 2) * kstep, b2 = last ? nB : cB + (unsigned)(t + 2) * kstep;
            const unsigned a3 = a2 + kstep, b3 = b2 + kstep;
            if (last && has_next) S.a_ready(nxt);
            if constexpr (SP2) {
            PG8_LDB(B0, 0, 0); PG8_LDB(B1, 0, 1); PG8_SCHED; PG8_LDA(At, 0, 0); PG8_STAGE(PG8_SA(1, 1), a1 + hstep, voffA);
            PG8_WAIT_V(8); PG8_WAIT_L(0); PG8_BAR; PG8_MMA(0, 0, At, B0); PG8_MMA(0, 1, At, B1); PG8_BAR; PG8_SCHED;
            PG8_LDA(At, 0, 1); PG8_STAGE(PG8_SB(0, 0), b2, voffB); PG8_STAGE(PG8_SB(0, 1), b2 + hstep, voffB); PG8_STAGE(PG8_SA(0, 0), a2, voffA);
            PG8_WAIT_V(8); PG8_WAIT_L(0); PG8_BAR; PG8_MMA(1, 0, At, B0); PG8_MMA(1, 1, At, B1); PG8_BAR; PG8_SCHED;
            PG8_LDB(B0, 1, 0); PG8_LDB(B1, 1, 1); PG8_SCHED; PG8_LDA(At, 1, 0); PG8_STAGE(PG8_SA(0, 1), a2 + hstep, voffA);
            PG8_WAIT_V(8); PG8_WAIT_L(0); PG8_BAR; PG8_MMA(0, 0, At, B0); PG8_MMA(0, 1, At, B1); PG8_BAR; PG8_SCHED;
            PG8_LDA(At, 1, 1); PG8_STAGE(PG8_SB(1, 0), b3, voffB); PG8_STAGE(PG8_SB(1, 1), b3 + hstep, voffB); PG8_STAGE(PG8_SA(1, 0), a3, voffA);
            PG8_WAIT_V(8); PG8_WAIT_L(0); PG8_BAR; PG8_MMA(1, 0, At, B0); PG8_MMA(1, 1, At, B1); PG8_BAR; PG8_SCHED;
            } else {
            PG8_LDB(B0, 0, 0); PG8_SCHED; PG8_LDA(At, 0, 0); PG8_STAGE(PG8_SA(1, 1), a1 + hstep, voffA);
            PG8_WAIT_L(8); PG8_BAR; PG8_WAIT_L(0); PG8_MMA(0, 0, At, B0); PG8_BAR; PG8_SCHED;
            PG8_LDB(B1, 0, 1); PG8_STAGE(PG8_SB(0, 0), b2, voffB);
            PG8_BAR; PG8_WAIT_L(0); PG8_MMA(0, 1, At, B1); PG8_BAR;
            PG8_LDA(At, 0, 1); PG8_STAGE(PG8_SA(0, 0), a2, voffA);
            PG8_BAR; PG8_WAIT_L(0); PG8_MMA(1, 0, At, B0); PG8_BAR; PG8_SCHED;
            PG8_STAGE(PG8_SB(0, 1), b2 + hstep, voffB);
            PG8_WAIT_V(6); PG8_BAR; PG8_MMA(1, 1, At, B1); PG8_BAR;
            PG8_LDB(B0, 1, 0); PG8_SCHED; PG8_LDA(At, 1, 0); PG8_STAGE(PG8_SA(0, 1), a2 + hstep, voffA);
            PG8_WAIT_L(8); PG8_BAR; PG8_WAIT_L(0); PG8_MMA(0, 0, At, B0); PG8_BAR; PG8_SCHED;
            PG8_LDB(B1, 1, 1); PG8_STAGE(PG8_SB(1, 0), b3, voffB);
            PG8_BAR; PG8_WAIT_L(0); PG8_MMA(0, 1, At, B1); PG8_BAR;
            PG8_LDA(At, 1, 1); PG8_STAGE(PG8_SA(1, 0), a3, voffA);
            PG8_BAR; PG8_WAIT_L(0); PG8_MMA(1, 0, At, B0); PG8_BAR; PG8_SCHED;
            PG8_STAGE(PG8_SB(1, 1), b3 + hstep, voffB);
            PG8_WAIT_V(6); PG8_BAR; PG8_MMA(1, 1, At, B1); PG8_BAR;
            }
        }
        if constexpr (ALIGN_EPI) { if (wr == 0) PG8_BAR; }
        if constexpr (!Epi::AFTER_DRAIN) { E(acc, cur, wr, wc, fr, fq); S.done(cur); }
        if (!has_next) break;
#pragma unroll
        for (int a = 0; a < 2; ++a)
#pragma unroll
            for (int b = 0; b < 2; ++b)
#pragma unroll
                for (int m = 0; m < 4; ++m)
#pragma unroll
                    for (int n = 0; n < 2; ++n) acc[a][b][m][n] = (f32x4){0.f, 0.f, 0.f, 0.f};
        cur = nxt; cA = nA; cB = nB; ++ui;
        if constexpr (ALIGN_EPI) { if (wr == 1) PG8_BAR; }
    }
    PG8_WAIT_V(0);
    if constexpr (!ALIGN_EPI) { if (wr == 0) PG8_BAR; }
    PG8_BAR;
    if constexpr (Epi::AFTER_DRAIN) { E.fused(acc, cur, wr, wc, fr, fq, lds, wid, lane); S.done(cur); }
#undef PG8_SA
#undef PG8_SB
#undef PG8_STAGE
#undef PG8_LDA
#undef PG8_LDB
#undef PG8_MMA
#undef PG8_WAIT_V
#undef PG8_WAIT_L
#undef PG8_BAR
#undef PG8_SCHED
}
}

constexpr int NWAVES = 8;
constexpr int BATCH = 16, SEQ = 2048, D = 1024, M = BATCH * SEQ, MEML = 256, MEMR = BATCH * MEML;
constexpr int NHS = 12, NKV0 = 3, NCH = 4, HD = 64, FF = 3584, NEXP = 8;
constexpr int N0 = 1536, N1 = 2560;
constexpr int P0_Q = 0, P0_K = 768, P0_V = 1024, P0_QC = 1216;
constexpr int P1_Q = 0, P1_K = 768, P1_V = 1536, P1_QC = 2304;
constexpr float RMS_EPS = 1e-6f, LOG2E = 1.4426950408889634f, QSCALE = 0.125f * LOG2E;
constexpr int SLOTS = 2 * M + NEXP * 256, TMAX = SLOTS / 256;
constexpr int CHT = 128, NCHUNK = 3;
#if MOE_FP8
constexpr int PH_FINAL = 16;
constexpr int TAIL_TILE0 = 256, TAIL_SLOT0 = TAIL_TILE0 * 256;
#else
constexpr int PH_FINAL = 19;
#endif
constexpr float XS_SCALE = 8.f, WGU_SCALE = 256.f, H_SCALE = 16.f, WDN_SCALE = 512.f;
constexpr int NPHASE = PH_FINAL + 1;

constexpr size_t MiB = 1u << 20;
constexpr size_t WS_CTL = 0, CTL_ZERO_BYTES = 1 * MiB;
constexpr size_t WS_TAB = 1 * MiB;
constexpr size_t TAB_ROWSC = 0, TAB_CSG = 128 * 1024, TAB_CSU = 160 * 1024, TAB_CS1 = 192 * 1024, TAB_CS0 = 208 * 1024, TAB_ROWSC0 = 384 * 1024;
constexpr size_t TAB_TOKE = 0, TAB_TOKW = 128 * 1024, TAB_TOKSLOT = 384 * 1024, TAB_WOFF = 640 * 1024, TAB_WGH = 704 * 1024, TAB_EST = 712 * 1024, TAB_SLOTW = 720 * 1024;
constexpr size_t WS_MIX = 2 * MiB;
#if MOE_FP8
constexpr size_t WS_W1GU = 2 * MiB, WS_W1DOWN = 58 * MiB;
constexpr size_t WS_XS = 86 * MiB;
constexpr size_t WS_XN8U = 152 * MiB;
constexpr size_t WS_YS = 152 * MiB;
constexpr size_t WS_HID8 = 284 * MiB;
#else
constexpr size_t WS_W1GU = 2 * MiB, WS_W1DOWN = 114 * MiB;
constexpr size_t WS_XS = 170 * MiB, WS_YS = 170 * MiB;
#endif
constexpr size_t WS_XN = 170 * MiB;
constexpr size_t WS_ROPE = 250 * MiB, WS_MEMKV = 258 * MiB;
constexpr size_t WS_W0IN = 266 * MiB, WS_W0OUT = 271 * MiB, WS_W0GU = 273 * MiB, WS_W0DOWN = 287 * MiB, WS_W1IN = 294 * MiB, WS_W1OUT = 299 * MiB;
constexpr size_t WS_HID = 302 * MiB;
constexpr size_t WS_PROJ = 302 * MiB, WS_ATT = 462 * MiB, WS_END = 526 * MiB;
#if MOE_FP8
static_assert(WS_W1GU + (size_t)NEXP * 2 * FF * D <= WS_W1DOWN && WS_W1DOWN + (size_t)NEXP * D * FF <= WS_XS && WS_XS + (size_t)SLOTS * D <= WS_YS && WS_YS + (size_t)SLOTS * D * 2 <= WS_HID8 && WS_HID8 + (size_t)SLOTS * FF <= WS_END, "d_ws map (fp8 experts)");
#else
static_assert(WS_XS + (size_t)SLOTS * D * 2 <= WS_HID && WS_W1DOWN + (size_t)NEXP * D * FF * 2 <= WS_XS, "d_ws map (bf16 experts)");
#endif
static_assert(WS_W1OUT + 2 * MiB <= WS_HID && WS_HID + (size_t)M * FF * 2 <= WS_END, "d_ws map");
constexpr int CW_TMO = 0, CW_BAR = 4096, CW_CMAX = 131072, CW_CMAX1 = CW_CMAX + 2 * FF;

constexpr int RING_OFF = 0, RING_BYTES = 131072;
constexpr int LDSCTL_OFF = RING_BYTES, MISC_OFF = LDSCTL_OFF + 320;
constexpr int ETAB_OFF = MISC_OFF + 128;
constexpr int LDS_BYTES = 147456;
static_assert(ETAB_OFF + 512 <= LDS_BYTES, "LDS map");

#define GAS __attribute__((address_space(1)))
#define LAS __attribute__((address_space(3)))
typedef unsigned short bf16;
typedef unsigned v4u __attribute__((ext_vector_type(4)));
typedef unsigned v2u __attribute__((ext_vector_type(2)));
typedef float f32x4 __attribute__((ext_vector_type(4)));
typedef GAS unsigned gu32;
#define RLX_AGENT __ATOMIC_RELAXED, __HIP_MEMORY_SCOPE_AGENT
#define LDS_WAIT() asm volatile("s_waitcnt lgkmcnt(0)" ::: "memory")
#define VM_WAIT() asm volatile("s_waitcnt vmcnt(0)" ::: "memory")
__device__ __forceinline__ unsigned f2bf(float f) { unsigned u = __builtin_bit_cast(unsigned, f); return (u + 0x7fffu + ((u >> 16) & 1u)) >> 16; }
__device__ __forceinline__ unsigned pk2(float lo, float hi) { return f2bf(lo) | (f2bf(hi) << 16); }
__device__ __forceinline__ float bflo(unsigned w) { return __uint_as_float(w << 16); }
__device__ __forceinline__ float bfhi(unsigned w) { return __uint_as_float(w & 0xffff0000u); }
template <class T> __device__ __forceinline__ const GAS T* vptr(const T* p) { unsigned long long a = (unsigned long long)p; unsigned lo = (unsigned)a, hi = (unsigned)(a >> 32); asm volatile("" : "+v"(lo), "+v"(hi)); return (const GAS T*)(((unsigned long long)hi << 32) | lo); }

#define XB_TMO      128
#define XB_XCNT(j)  (256  + 64 * (j))
#define XB_XSUB(j)  (1280 + 64 * (j))
#define XB_XGEN(j)  (2304 + 64 * (j))
#define XB_TOP      3328
#define XB_TOPGEN   3392
#define XCD_BAR_WORDS 3456
#define XB_SPIN_CAP (1u << 22)

__device__ __forceinline__ unsigned xb_ld(unsigned* p)              { return __hip_atomic_load(p, __ATOMIC_RELAXED, __HIP_MEMORY_SCOPE_AGENT); }
__device__ __forceinline__ unsigned xb_add(unsigned* p, unsigned v) { return __hip_atomic_fetch_add(p, v, __ATOMIC_RELAXED, __HIP_MEMORY_SCOPE_AGENT); }
__device__ __forceinline__ unsigned xb_xcc_id() { return (unsigned)__builtin_amdgcn_s_getreg((3 << 11) | 20) & 0xFu; }
#define XB_SPIN(cond, bar) do { unsigned _sp = 0; while (cond) { __builtin_amdgcn_s_sleep(1); \
    if ((++_sp & 255u) == 0u) { if (xb_ld(&(bar)[XB_TMO])) break; if (_sp > XB_SPIN_CAP) { atomicAdd(&(bar)[XB_TMO], 1u); break; } } } } while (0)

struct XcdBarrier {
    unsigned* bar; unsigned x;
    volatile LAS unsigned* st;
};

__device__ __forceinline__ XcdBarrier xcd_barrier_post(unsigned* bar, volatile LAS unsigned* st) {
    XcdBarrier b; b.bar = bar; b.x = xb_xcc_id(); b.st = st;
    if (threadIdx.x == 0) (void)xb_add(&bar[XB_XCNT(b.x)], 1u);
    return b;
}
__device__ __forceinline__ void xcd_barrier_complete(unsigned* bar, unsigned x, unsigned& nloc, unsigned& nx) {
    const unsigned G = gridDim.x * gridDim.y * gridDim.z;
    unsigned sum, cnt, mine, sp = 0u;
    for (;;) {
        sum = 0u; cnt = 0u; mine = 0u;
#pragma unroll
        for (unsigned j = 0; j < 16; ++j) { const unsigned c = xb_ld(&bar[XB_XCNT(j)]); sum += c; cnt += (c > 0u) ? 1u : 0u; mine = (j == x) ? c : mine; }
        if (sum == G) break;
        __builtin_amdgcn_s_sleep(1);
        if ((++sp & 255u) == 0u) { if (xb_ld(&bar[XB_TMO])) break; if (sp > XB_SPIN_CAP) { atomicAdd(&bar[XB_TMO], 1u); break; } }
    }
    nloc = mine > 0u ? mine : 1u; nx = cnt > 0u ? cnt : 1u;
}

__device__ __forceinline__ void xcd_barrier(const XcdBarrier& b) {
    asm volatile("s_waitcnt vmcnt(0)" ::: "memory");
    __syncthreads();
    if (threadIdx.x == 0) {
        unsigned* bar = b.bar;
        __builtin_amdgcn_s_waitcnt(0);
        unsigned nloc = b.st[0], nx = b.st[1];
        if (nloc == 0u) { xcd_barrier_complete(bar, b.x, nloc, nx); b.st[0] = nloc; b.st[1] = nx; }
        const unsigned old = xb_add(&bar[XB_XSUB(b.x)], 1u);
        const unsigned gen = old / nloc;
        if (old + 1u == (gen + 1u) * nloc) {
            __builtin_amdgcn_fence(__ATOMIC_RELEASE, "agent");
            asm volatile("s_waitcnt vmcnt(0)" ::: "memory");
            const unsigned og = xb_add(&bar[XB_TOP], 1u);
            const unsigned tg = og / nx;
            if (og + 1u == (tg + 1u) * nx) xb_add(&bar[XB_TOPGEN], 1u);
            else XB_SPIN(xb_ld(&bar[XB_TOPGEN]) == tg, bar);
            __builtin_amdgcn_fence(__ATOMIC_ACQUIRE, "agent");
            xb_add(&bar[XB_XGEN(b.x)], 1u);
            asm volatile("s_waitcnt vmcnt(0)" ::: "memory");
        } else {
            XB_SPIN(xb_ld(&bar[XB_XGEN(b.x)]) == gen, bar);
            __builtin_amdgcn_fence(__ATOMIC_ACQUIRE, "agent");
            asm volatile("s_waitcnt vmcnt(0)" ::: "memory");
        }
    }
    __syncthreads();
}

struct Args { const void* in[27]; float* out; unsigned char* ws; int ph_lo, ph_hi, li, pad; };
struct Frame {
    LAS unsigned char* lds; volatile LAS unsigned* MISC; gu32* ctl;
    int tid, lane, wave, G, c;
    unsigned char* ws; float* out;
};
__device__ __forceinline__ void refresh_ids(Frame& F) { int l; asm volatile("v_mbcnt_lo_u32_b32 %0, -1, 0\n\tv_mbcnt_hi_u32_b32 %0, -1, %0" : "=v"(l)); F.lane = l; F.tid = F.wave * 64 + l; }
__device__ __forceinline__ float wave_sum(float v) {
#pragma unroll
    for (int o = 1; o < 64; o <<= 1) v += __shfl_xor(v, o);
    return v;
}
__device__ __forceinline__ int wave_sum_i(int v) {
#pragma unroll
    for (int o = 1; o < 64; o <<= 1) v += __shfl_xor(v, o);
    return v;
}
__device__ __forceinline__ void ld_row_f32(const float* row, int lane, f32x4 (&v)[4]) {
#pragma unroll
    for (int j = 0; j < 4; ++j) v[j] = *(const f32x4*)(row + 4 * lane + 256 * j);
}
__device__ __forceinline__ void st_row_f32(float* row, int lane, const f32x4 (&v)[4]) {
#pragma unroll
    for (int j = 0; j < 4; ++j) *(f32x4*)(row + 4 * lane + 256 * j) = v[j];
}
__device__ __forceinline__ void ld_row_bf16(const bf16* row, int lane, f32x4 (&v)[4]) {
#pragma unroll
    for (int j = 0; j < 4; ++j) { const v2u w = *(const v2u*)(row + 4 * lane + 256 * j); v[j] = (f32x4){bflo(w.x), bfhi(w.x), bflo(w.y), bfhi(w.y)}; }
}
__device__ __forceinline__ void st_row_bf16(bf16* row, int lane, const f32x4 (&v)[4]) {
#pragma unroll
    for (int j = 0; j < 4; ++j) { v2u w; w.x = pk2(v[j][0], v[j][1]); w.y = pk2(v[j][2], v[j][3]); *(v2u*)(row + 4 * lane + 256 * j) = w; }
}
__device__ __forceinline__ float row_rstd(const f32x4 (&v)[4]) {
    float s = 0.f;
#pragma unroll
    for (int j = 0; j < 4; ++j) s += (v[j][0] * v[j][0] + v[j][1] * v[j][1]) + (v[j][2] * v[j][2] + v[j][3] * v[j][3]);
    return 1.0f / sqrtf(wave_sum(s) * (1.0f / D) + RMS_EPS);
}

struct ColSrc { const float* W; int N; int col; float scale; };
struct MapIn0 { const float* W;
    __device__ __forceinline__ ColSrc operator()(int n) const { ColSrc s; s.W = W; s.N = 1408; s.scale = 1.f; s.col = 0;
        if (n < 960) { const int h = n >> 6, p = n & 63; s.col = h * 64 + ((p >> 2) & 1) * 32 + (p >> 5) * 16 + ((p >> 3) & 3) * 4 + (p & 3); if (n < 768) s.scale = QSCALE; }
        else if (n < 1024) s.W = nullptr;
        else if (n < 1216) s.col = 960 + (n - 1024);
        else if (n < 1472) { s.col = 1152 + (n - 1216); s.scale = QSCALE; }
        else s.W = nullptr;
        return s; } };
struct MapIdent { const float* W; int N; int lo_end, hi_begin; float s_edge, s_mid;
    __device__ __forceinline__ ColSrc operator()(int n) const { ColSrc s; s.W = W; s.N = N; s.col = n; s.scale = (n < lo_end || n >= hi_begin) ? s_edge : s_mid; return s; } };
struct MapGU { const float* g; const float* u; float sc;
    __device__ __forceinline__ ColSrc operator()(int n) const { ColSrc s; const int j = n >> 8, r = n & 255; const long long du = (long long)((const char*)u - (const char*)g);
        s.W = (const float*)((const char*)g + (r < 128 ? 0ll : du)); s.N = FF; s.col = 128 * j + (r & 127); s.scale = sc; return s; } };
__device__ __forceinline__ unsigned pk4_i8(float a, float b, float c, float d) {
    const int qa = (int)__builtin_rintf(__builtin_amdgcn_fmed3f(a, -127.f, 127.f)), qb = (int)__builtin_rintf(__builtin_amdgcn_fmed3f(b, -127.f, 127.f)), qc = (int)__builtin_rintf(__builtin_amdgcn_fmed3f(c, -127.f, 127.f)), qd = (int)__builtin_rintf(__builtin_amdgcn_fmed3f(d, -127.f, 127.f));
    return ((unsigned)qa & 0xffu) | (((unsigned)qb & 0xffu) << 8) | (((unsigned)qc & 0xffu) << 16) | ((unsigned)qd << 24); }
struct MapGUq { const float* g; const float* u; const unsigned* cmax;
    __device__ __forceinline__ ColSrc operator()(int n) const { ColSrc s; const int j = n >> 8, r = n & 255, isu = r >> 7; const long long du = (long long)((const char*)u - (const char*)g);
        s.W = (const float*)((const char*)g + (isu ? du : 0ll)); s.N = FF; s.col = 128 * j + (r & 127);
        const float am = __uint_as_float(__hip_atomic_load(cmax + isu * FF + s.col, __ATOMIC_RELAXED, __HIP_MEMORY_SCOPE_AGENT)); s.scale = am > 0.f ? 127.0f / am : 0.f; return s; } };
struct MapIdentQ { const float* W; int N; const unsigned* cmax;
    __device__ __forceinline__ ColSrc operator()(int n) const { ColSrc s; s.W = W; s.N = N; s.col = n; const float am = __uint_as_float(__hip_atomic_load(cmax + n, __ATOMIC_RELAXED, __HIP_MEMORY_SCOPE_AGENT)); s.scale = am > 0.f ? 127.0f / am : 0.f; return s; } };
template <class Map> struct MapScaled { Map inner; float sc;
    __device__ __forceinline__ ColSrc operator()(int n) const { ColSrc s = inner(n); s.scale = sc; return s; } };
template <int OM  , class Map> __device__ __forceinline__ void transpose_item(const Map& map, int K, void* WT, int nblk, LAS float* scr, int item, int lane) {
    constexpr bool FP8 = (OM != 0); constexpr int KT = FP8 ? 128 : 64, KC = FP8 ? 16 : 8, SH = FP8 ? 4 : 3;
    const int kb = item / nblk, nb = item % nblk, k0 = KT * kb, n0 = 32 * nb;
    const ColSrc cs = map(n0 + pg8::perm32(lane & 31));
    float v[KT / 2];
    if (cs.W) { const float* src = cs.W + (size_t)(k0 + (lane >> 5)) * cs.N + cs.col;
#pragma unroll
        for (int i = 0; i < KT / 2; ++i) v[i] = __builtin_nontemporal_load(src + (size_t)(2 * i) * cs.N); }
    else {
#pragma unroll
        for (int i = 0; i < KT / 2; ++i) v[i] = 0.f; }
#pragma unroll
    for (int i = 0; i < KT / 2; ++i) { const int kk = 2 * i + (lane >> 5); scr[kk * 32 + (((lane & 31) + 4 * (kk >> SH)) & 31)] = v[i] * cs.scale; }
    LDS_WAIT(); asm volatile("" ::: "memory");
    const int c = lane & 7;
#pragma unroll
    for (int j = 0; j < 4; ++j) { const int n = (lane >> 3) + 8 * j; const LAS float* s = scr + (KC * c) * 32 + ((n + 4 * c) & 31);
        v4u o;
        if (OM == 2) { o.x = pk4_i8(s[0 * 32], s[1 * 32], s[2 * 32], s[3 * 32]); o.y = pk4_i8(s[4 * 32], s[5 * 32], s[6 * 32], s[7 * 32]); o.z = pk4_i8(s[8 * 32], s[9 * 32], s[10 * 32], s[11 * 32]); o.w = pk4_i8(s[12 * 32], s[13 * 32], s[14 * 32], s[15 * 32]);
            *(GAS v4u*)((unsigned char*)WT + (size_t)(n0 + n) * K + k0 + 16 * c) = o; }
        else if (FP8) { o.x = pg8::pk4_fp8(s[0 * 32], s[1 * 32], s[2 * 32], s[3 * 32]); o.y = pg8::pk4_fp8(s[4 * 32], s[5 * 32], s[6 * 32], s[7 * 32]); o.z = pg8::pk4_fp8(s[8 * 32], s[9 * 32], s[10 * 32], s[11 * 32]); o.w = pg8::pk4_fp8(s[12 * 32], s[13 * 32], s[14 * 32], s[15 * 32]);
            *(GAS v4u*)((unsigned char*)WT + (size_t)(n0 + n) * K + k0 + 16 * c) = o; }
        else { o.x = pk2(s[0 * 32], s[1 * 32]); o.y = pk2(s[2 * 32], s[3 * 32]); o.z = pk2(s[4 * 32], s[5 * 32]); o.w = pk2(s[6 * 32], s[7 * 32]);
            *(GAS v4u*)((bf16*)WT + (size_t)(n0 + n) * K + k0 + 8 * c) = o; } }
    LDS_WAIT(); asm volatile("" ::: "memory");
}

__device__ __forceinline__ void p0_prologue(const Args& a, Frame& F) {
    LAS float* scr = (LAS float*)(F.lds + RING_OFF + F.wave * 16384);
    const int gw = F.c * NWAVES + F.wave, NGW = F.G * NWAVES;
    constexpr int I_IN0 = 16 * 48, I_KV = 16 * 16, I_OUT = 16 * 32, I_GU = 16 * 224, I_DN = 56 * 32, I_IN1 = 16 * 80;
    constexpr int NITEMS = I_IN0 + 2 * I_KV + 2 * I_OUT + I_GU + I_DN + I_IN1;
    bf16* w0in = (bf16*)(F.ws + WS_W0IN);
    for (int it = gw; it < NITEMS; it += NGW) {
        int r = it;
#if PROJ0_I8
        if (r < I_IN0 + 2 * I_KV) {
            if (r >= 80) continue;
            const int nb = r, n = 32 * nb + pg8::perm32(F.lane & 31);
            ColSrc cs; float extra = 1.f;
            if (nb < 48) { cs = MapIn0{(const float*)a.in[5]}(n); extra = cs.scale; }
            else if (nb < 64) cs = MapIdent{(const float*)a.in[6], 512, 0, 1 << 30, 1.f, 1.f}(n - 1536);
            else cs = MapIdent{(const float*)a.in[18], 512, 0, 1 << 30, 1.f, 1.f}(n - 2048);
            float am = 0.f;
            if (cs.W) { const float* src = cs.W + (size_t)(F.lane >> 5) * cs.N + cs.col;
                for (int k = 0; k < 512; k += 32) {
#pragma unroll
                    for (int i = 0; i < 32; ++i) am = fmaxf(am, fabsf(src[(size_t)(2 * (k + i)) * cs.N])); } }
            am = fmaxf(am, __shfl_xor(am, 32));
            const float sc = am > 0.f ? 127.0f / am : 0.f;
            if (F.lane < 32) ((float*)(F.ws + WS_TAB + TAB_CS0))[32 * nb + pg8::perm32(F.lane)] = am * (1.0f / 127.0f) * extra;
            for (int kb = 0; kb < 8; ++kb) {
                if (nb < 48) transpose_item<2>(MapScaled<MapIn0>{MapIn0{(const float*)a.in[5]}, sc}, D, (unsigned char*)w0in, 80, scr, kb * 80 + nb, F.lane);
                else if (nb < 64) transpose_item<2>(MapScaled<MapIdent>{MapIdent{(const float*)a.in[6], 512, 0, 1 << 30, 1.f, 1.f}, sc}, D, (unsigned char*)w0in + (size_t)1536 * D, 16, scr, kb * 16 + (nb - 48), F.lane);
                else transpose_item<2>(MapScaled<MapIdent>{MapIdent{(const float*)a.in[18], 512, 0, 1 << 30, 1.f, 1.f}, sc}, D, (unsigned char*)w0in + (size_t)2048 * D, 16, scr, kb * 16 + (nb - 64), F.lane); }
            continue; } r -= I_IN0 + 2 * I_KV;
#else
        if (r < I_IN0) { transpose_item<0>(MapIn0{(const float*)a.in[5]}, D, w0in, 48, scr, r, F.lane); continue; } r -= I_IN0;
        if (r < I_KV) { transpose_item<0>(MapIdent{(const float*)a.in[6], 512, 0, 1 << 30, 1.f, 1.f}, D, w0in + (size_t)1536 * D, 16, scr, r, F.lane); continue; } r -= I_KV;
        if (r < I_KV) { transpose_item<0>(MapIdent{(const float*)a.in[18], 512, 0, 1 << 30, 1.f, 1.f}, D, w0in + (size_t)2048 * D, 16, scr, r, F.lane); continue; } r -= I_KV;
#endif
        if (r < I_OUT) { transpose_item<0>(MapIdent{(const float*)a.in[8], D, 0, 1 << 30, 1.f, 1.f}, D, (bf16*)(F.ws + WS_W0OUT), 32, scr, r, F.lane); continue; } r -= I_OUT;
        if (r < I_OUT) { transpose_item<0>(MapIdent{(const float*)a.in[19], D, 0, 1 << 30, 1.f, 1.f}, D, (bf16*)(F.ws + WS_W1OUT), 32, scr, r, F.lane); continue; } r -= I_OUT;
#if FFN0_MODE == 2
        if (r < I_GU) {
            const int isu = r >= I_GU / 2, rr = r - isu * (I_GU / 2), kb = rr / 112, nb = rr % 112; const float* W = (const float*)a.in[11 + isu] + (size_t)(64 * kb + (F.lane >> 5)) * FF + 32 * nb + (F.lane & 31);
            float am = 0.f;
#pragma unroll
            for (int i = 0; i < 32; ++i) am = fmaxf(am, fabsf(W[(size_t)(2 * i) * FF]));
            am = fmaxf(am, __shfl_xor(am, 32));
            if (F.lane < 32) atomicMax((unsigned*)(F.ctl + CW_CMAX) + isu * FF + 32 * nb + F.lane, __float_as_uint(am));
            continue; } r -= I_GU;
#else
        if (r < I_GU) { transpose_item<0>(MapGU{(const float*)a.in[11], (const float*)a.in[12], 1.f}, D, (bf16*)(F.ws + WS_W0GU), 224, scr, r, F.lane); continue; } r -= I_GU;
#endif
#if DOWN0_FP8 && FFN0_MODE == 2
        if (r < I_DN) { if (r < I_DN / 2) transpose_item<1>(MapIdent{(const float*)a.in[13], D, 0, 1 << 30, 1.f, WDN_SCALE}, FF, F.ws + WS_W0DOWN, 32, scr, r, F.lane); continue; } r -= I_DN;
#else
        if (r < I_DN) { transpose_item<0>(MapIdent{(const float*)a.in[13], D, 0, 1 << 30, 1.f, 1.f}, FF, (bf16*)(F.ws + WS_W0DOWN), 32, scr, r, F.lane); continue; } r -= I_DN;
#endif
#if PROJ1_I8
        {
            const int kb = r / 80, nb = r % 80; const float* W = (const float*)a.in[17] + (size_t)(64 * kb + (F.lane >> 5)) * N1 + 32 * nb + (F.lane & 31);
            float am = 0.f;
#pragma unroll
            for (int i = 0; i < 32; ++i) am = fmaxf(am, fabsf(W[(size_t)(2 * i) * N1]));
            am = fmaxf(am, __shfl_xor(am, 32));
            if (F.lane < 32) atomicMax((unsigned*)(F.ctl + CW_CMAX1) + 32 * nb + F.lane, __float_as_uint(am)); }
#else
        transpose_item<0>(MapIdent{(const float*)a.in[17], N1, 768, 2304, QSCALE, 1.f}, D, (bf16*)(F.ws + WS_W1IN), 80, scr, r, F.lane);
#endif
    }
    bf16* xn = (bf16*)(F.ws + WS_XN);
    for (int r = gw; r < M + 2 * MEMR; r += NGW) {
        const float* src; const float* g;
        if (r < M) { src = (const float*)a.in[0] + (size_t)r * D; g = (const float*)a.in[3]; }
        else if (r < M + MEMR) { src = (const float*)a.in[1] + (size_t)(r - M) * D; g = (const float*)a.in[4]; }
        else { src = (const float*)a.in[1] + (size_t)(r - M - MEMR) * D; g = (const float*)a.in[16]; }
        f32x4 v[4], gv[4]; ld_row_f32(src, F.lane, v); ld_row_f32(g, F.lane, gv);
        const float rs = row_rstd(v);
#pragma unroll
        for (int j = 0; j < 4; ++j) v[j] = v[j] * rs * gv[j];
#if PROJ0_I8
        {   float am = 0.f;
#pragma unroll
            for (int j = 0; j < 4; ++j) am = fmaxf(fmaxf(am, fmaxf(fabsf(v[j][0]), fabsf(v[j][1]))), fmaxf(fabsf(v[j][2]), fabsf(v[j][3])));
#pragma unroll
            for (int o = 1; o < 64; o <<= 1) am = fmaxf(am, __shfl_xor(am, o));
            const float inv = am > 0.f ? 127.0f / am : 0.f;
#pragma unroll
            for (int j = 0; j < 4; ++j) *(unsigned*)((unsigned char*)xn + (size_t)r * D + 4 * F.lane + 256 * j) = pk4_i8(v[j][0] * inv, v[j][1] * inv, v[j][2] * inv, v[j][3] * inv);
            if (F.lane == 0) ((float*)(F.ws + WS_TAB + TAB_ROWSC0))[r] = am * (1.0f / 127.0f); }
#else
        st_row_bf16(xn + (size_t)r * D, F.lane, v);
#endif
    }
    float* rope = (float*)(F.ws + WS_ROPE); const int* pos = (const int*)a.in[2];
    for (int idx = F.c * (NWAVES * 64) + F.tid; idx < M * 32; idx += F.G * NWAVES * 64) {
        const int m = idx >> 5, i = idx & 31;
        const float inv_freq = exp2f(-(float)i * (13.287712379549449f / 32.0f));
        const float ang = (float)pos[m] * inv_freq;
        const double rev = (double)ang * 0.15915494309189535; const float fr = (float)(rev - floor(rev));
        rope[(size_t)m * 64 + i] = __builtin_amdgcn_cosf(fr); rope[(size_t)m * 64 + 32 + i] = __builtin_amdgcn_sinf(fr);
    }
}

template <int XM> __device__ __forceinline__ void phase_norm_res(Frame& F, const bf16* mix, const float* hin, const float* gpost, const float* gnext, bf16* xn, float* rowscale) {
    f32x4 gp[4], gn[4]; ld_row_f32(gpost, F.lane, gp); ld_row_f32(gnext, F.lane, gn);
    for (int i = 0; i < 16; ++i) { const size_t m = (size_t)(128 * F.c + 16 * F.wave + i);
        f32x4 v[4], h[4]; ld_row_bf16(mix + m * D, F.lane, v); ld_row_f32(hin + m * D, F.lane, h);
        const float rs = row_rstd(v);
#pragma unroll
        for (int j = 0; j < 4; ++j) h[j] = h[j] + v[j] * rs * gp[j];
        st_row_f32(F.out + m * D, F.lane, h);
        const float rs2 = row_rstd(h);
#pragma unroll
        for (int j = 0; j < 4; ++j) v[j] = h[j] * rs2 * gn[j];
        if (XM == 2) { float am = 0.f;
#pragma unroll
            for (int j = 0; j < 4; ++j) am = fmaxf(fmaxf(am, fmaxf(fabsf(v[j][0]), fabsf(v[j][1]))), fmaxf(fabsf(v[j][2]), fabsf(v[j][3])));
#pragma unroll
            for (int o = 1; o < 64; o <<= 1) am = fmaxf(am, __shfl_xor(am, o));
            const float inv = am > 0.f ? 127.0f / am : 0.f;
#pragma unroll
            for (int j = 0; j < 4; ++j) *(unsigned*)((unsigned char*)xn + m * D + 4 * F.lane + 256 * j) = pk4_i8(v[j][0] * inv, v[j][1] * inv, v[j][2] * inv, v[j][3] * inv);
            if (F.lane == 0) rowscale[m] = am * (1.0f / 127.0f); }
        else st_row_bf16(xn + m * D, F.lane, v); }
}
__device__ __forceinline__ void phase_route(const Args& a, Frame& F) {
    const bf16* mix = (const bf16*)(F.ws + WS_MIX); const float* wr = (const float*)a.in[22];
    int* tok_e = (int*)(F.ws + WS_TAB + TAB_TOKE); float* tok_w = (float*)(F.ws + WS_TAB + TAB_TOKW);
    int* woff = (int*)(F.ws + WS_TAB + TAB_WOFF); int* wgh = (int*)(F.ws + WS_TAB + TAB_WGH);
    f32x4 gp[4], gn[4]; ld_row_f32((const float*)a.in[20], F.lane, gp); ld_row_f32((const float*)a.in[21], F.lane, gn);
    unsigned long long cnt = 0ull;
    for (int i = 0; i < 16; ++i) { const size_t m = (size_t)(128 * F.c + 16 * F.wave + i);
        f32x4 v[4], h[4]; ld_row_bf16(mix + m * D, F.lane, v); ld_row_f32(F.out + m * D, F.lane, h);
        const float rs = row_rstd(v);
#pragma unroll
        for (int j = 0; j < 4; ++j) h[j] = h[j] + v[j] * rs * gp[j];
        st_row_f32(F.out + m * D, F.lane, h);
        const float rs2 = row_rstd(h);
        float lg[8];
#pragma unroll
        for (int e = 0; e < 8; ++e) lg[e] = 0.f;
#pragma unroll
        for (int j = 0; j < 4; ++j) { const f32x4 x = h[j] * rs2 * gn[j];
#if MOE_FP8
            *(unsigned*)(F.ws + WS_XN8U + m * D + 4 * F.lane + 256 * j) = pg8::pk4_fp8(x[0] * XS_SCALE, x[1] * XS_SCALE, x[2] * XS_SCALE, x[3] * XS_SCALE);
#endif
#pragma unroll
            for (int q = 0; q < 4; ++q) { const float* wp = wr + (size_t)(4 * F.lane + 256 * j + q) * 8; const f32x4 w0 = *(const f32x4*)wp, w1 = *(const f32x4*)(wp + 4);
                lg[0] += x[q] * w0[0]; lg[1] += x[q] * w0[1]; lg[2] += x[q] * w0[2]; lg[3] += x[q] * w0[3]; lg[4] += x[q] * w1[0]; lg[5] += x[q] * w1[1]; lg[6] += x[q] * w1[2]; lg[7] += x[q] * w1[3]; } }
#pragma unroll
        for (int e = 0; e < 8; ++e) lg[e] = wave_sum(lg[e]);
        int e0 = 0; float v0 = lg[0];
#pragma unroll
        for (int e = 1; e < 8; ++e) if (lg[e] > v0) { v0 = lg[e]; e0 = e; }
        int e1 = -1; float v1 = -INFINITY;
#pragma unroll
        for (int e = 0; e < 8; ++e) if (e != e0 && lg[e] > v1) { v1 = lg[e]; e1 = e; }
        if (e1 < 0) e1 = (e0 + 1) & 7;
        const float ex = __expf(v1 - v0), w0 = 1.0f / (1.0f + ex), w1 = ex * w0;
        const unsigned r0 = (unsigned)(cnt >> (8 * e0)) & 0xffu; cnt += 1ull << (8 * e0);
        const unsigned r1 = (unsigned)(cnt >> (8 * e1)) & 0xffu; cnt += 1ull << (8 * e1);
        if (F.lane == 0) { tok_e[m] = e0 | (e1 << 4) | (int)(r0 << 8) | (int)(r1 << 16); tok_w[2 * m] = w0; tok_w[2 * m + 1] = w1; } }
    LAS unsigned* wh = (LAS unsigned*)(F.lds + RING_OFF);
    if (F.lane < 8) wh[F.wave * 8 + F.lane] = (unsigned)(cnt >> (8 * F.lane)) & 0xffu;
    __syncthreads();
    if (F.tid < 8) { unsigned run = 0u;
        for (int w = 0; w < 8; ++w) { woff[(F.c * 8 + w) * 8 + F.tid] = (int)run; run += wh[w * 8 + F.tid]; }
        wgh[F.c * 8 + F.tid] = (int)run; }
    __syncthreads();
}
__device__ __forceinline__ void phase_permute(const Args& a, Frame& F) {
    const int* tok_e = (const int*)(F.ws + WS_TAB + TAB_TOKE); const float* tok_w = (const float*)(F.ws + WS_TAB + TAB_TOKW);
    int* tok_slot = (int*)(F.ws + WS_TAB + TAB_TOKSLOT); const int* woff = (const int*)(F.ws + WS_TAB + TAB_WOFF); const int* wgh = (const int*)(F.ws + WS_TAB + TAB_WGH);
    int* est_g = (int*)(F.ws + WS_TAB + TAB_EST); float* slot_w = (float*)(F.ws + WS_TAB + TAB_SLOTW);
    LAS int* part = (LAS int*)(F.lds + RING_OFF);
    LAS int* basew = (LAS int*)(F.lds + RING_OFF + 1024);
    if (F.tid < 256) {
        int hv[8];
#pragma unroll
        for (int e = 0; e < 8; ++e) hv[e] = wgh[F.tid * 8 + e];
#pragma unroll
        for (int e = 0; e < 8; ++e) { const int tot = wave_sum_i(hv[e]), pre = wave_sum_i(F.tid < F.c ? hv[e] : 0);
            if (F.lane == 0) { part[F.wave * 16 + e] = tot; part[F.wave * 16 + 8 + e] = pre; } }
    }
    __syncthreads();
    int est[9], pre[8]; est[0] = 0;
#pragma unroll
    for (int e = 0; e < 8; ++e) { const int tot = part[e] + part[16 + e] + part[32 + e] + part[48 + e]; pre[e] = part[8 + e] + part[24 + e] + part[40 + e] + part[56 + e]; est[e + 1] = est[e] + ((tot + 255) & ~255); }
    if (F.c == 0 && F.tid == 0) {
#pragma unroll
        for (int k = 0; k < 9; ++k) est_g[k] = est[k];
    }
    if (F.lane < 8) { int b = 0;
#pragma unroll
        for (int e = 0; e < 8; ++e) if (F.lane == e) b = est[e] + pre[e];
        basew[F.wave * 8 + F.lane] = b + woff[(F.c * 8 + F.wave) * 8 + F.lane]; }
    LDS_WAIT(); asm volatile("" ::: "memory");
    bf16* xs = (bf16*)(F.ws + WS_XS);
#if MOE_FP8
    {
        const size_t mb = (size_t)(128 * F.c + 16 * F.wave);
        unsigned w[16][4]; int sa[16], sb[16];
#pragma unroll
        for (int i = 0; i < 16; ++i) {
#pragma unroll
            for (int j = 0; j < 4; ++j) w[i][j] = *(const unsigned*)(F.ws + WS_XN8U + (mb + i) * D + 4 * F.lane + 256 * j); }
#pragma unroll
        for (int i = 0; i < 16; ++i) { const size_t m = mb + i;
            const int te = tok_e[m]; const int e0 = te & 15, e1 = (te >> 4) & 15, r0 = (te >> 8) & 255, r1 = (te >> 16) & 255;
            sa[i] = basew[F.wave * 8 + e0] + r0; sb[i] = basew[F.wave * 8 + e1] + r1;
            if (F.lane == 0) { tok_slot[2 * m] = sa[i]; tok_slot[2 * m + 1] = sb[i]; slot_w[sa[i]] = tok_w[2 * m]; slot_w[sb[i]] = tok_w[2 * m + 1]; } }
#pragma unroll
        for (int i = 0; i < 16; ++i) {
#pragma unroll
            for (int j = 0; j < 4; ++j) { *(unsigned*)((unsigned char*)xs + (size_t)sa[i] * D + 4 * F.lane + 256 * j) = w[i][j]; *(unsigned*)((unsigned char*)xs + (size_t)sb[i] * D + 4 * F.lane + 256 * j) = w[i][j]; } }
    }
#else
    f32x4 gn[4]; ld_row_f32((const float*)a.in[21], F.lane, gn);
    for (int i = 0; i < 16; ++i) { const size_t m = (size_t)(128 * F.c + 16 * F.wave + i);
        const int te = tok_e[m]; const int e0 = te & 15, e1 = (te >> 4) & 15, r0 = (te >> 8) & 255, r1 = (te >> 16) & 255;
        const int s0 = basew[F.wave * 8 + e0] + r0, s1 = basew[F.wave * 8 + e1] + r1;
        if (F.lane == 0) { tok_slot[2 * m] = s0; tok_slot[2 * m + 1] = s1; slot_w[s0] = tok_w[2 * m]; slot_w[s1] = tok_w[2 * m + 1]; }
        f32x4 h[4]; ld_row_f32(F.out + m * D, F.lane, h);
        const float rs = row_rstd(h);
#pragma unroll
        for (int j = 0; j < 4; ++j) h[j] = h[j] * rs * gn[j];
        st_row_bf16(xs + (size_t)s0 * D, F.lane, h); st_row_bf16(xs + (size_t)s1 * D, F.lane, h); }
#endif
    __syncthreads();
    LAS float* scr = (LAS float*)(F.lds + RING_OFF + F.wave * 16384);
    const int gw = F.c * NWAVES + F.wave, NGW = F.G * NWAVES;
#if MOE_FP8
    constexpr int I_GU = 8 * 224, I_DN = 28 * 32, I_E = I_GU + I_DN;
    for (int it = gw; it < NEXP * I_E; it += NGW) { const int e = it / I_E, r = it % I_E;
        if (r < I_GU) transpose_item<1>(MapGU{(const float*)a.in[23] + (size_t)e * D * FF, (const float*)a.in[24] + (size_t)e * D * FF, WGU_SCALE}, D, F.ws + WS_W1GU + (size_t)e * 2 * FF * D, 224, scr, r, F.lane);
        else transpose_item<1>(MapIdent{(const float*)a.in[25] + (size_t)e * FF * D, D, 0, 1 << 30, 1.f, WDN_SCALE}, FF, F.ws + WS_W1DOWN + (size_t)e * D * FF, 32, scr, r - I_GU, F.lane); }
#else
    constexpr int I_GU = 16 * 224, I_DN = 56 * 32, I_E = I_GU + I_DN;
    for (int it = gw; it < NEXP * I_E; it += NGW) { const int e = it / I_E, r = it % I_E;
        if (r < I_GU) transpose_item<0>(MapGU{(const float*)a.in[23] + (size_t)e * D * FF, (const float*)a.in[24] + (size_t)e * D * FF, 1.f}, D, (bf16*)(F.ws + WS_W1GU) + (size_t)e * 2 * FF * D, 224, scr, r, F.lane);
        else transpose_item<0>(MapIdent{(const float*)a.in[25] + (size_t)e * FF * D, D, 0, 1 << 30, 1.f, 1.f}, FF, (bf16*)(F.ws + WS_W1DOWN) + (size_t)e * D * FF, 32, scr, r - I_GU, F.lane); }
#endif
}
__device__ __forceinline__ int build_expert_table(Frame& F) {
    const GAS int* est_g = vptr((const int*)(F.ws + WS_TAB + TAB_EST));
    int est[9];
#pragma unroll
    for (int k = 0; k < 9; ++k) est[k] = est_g[k];
    LAS unsigned char* tab = F.lds + ETAB_OFF;
    if (F.tid < TMAX) { const int r = F.tid * 256; int e = 0;
#pragma unroll
        for (int k = 1; k < 8; ++k) e += (r >= est[k]) ? 1 : 0;
        tab[F.tid] = (unsigned char)e; }
    __syncthreads();
    return __builtin_amdgcn_readfirstlane(est[8]) >> 8;
}
__device__ __forceinline__ void final_row(const bf16* ys, size_t m, int s0, int s1, const f32x4 (&gp)[4], Frame& F, bool poison) {
    const float qnan = __builtin_nanf("");
    f32x4 y0[4], y1[4], h[4]; ld_row_bf16(ys + (size_t)s0 * D, F.lane, y0); ld_row_bf16(ys + (size_t)s1 * D, F.lane, y1); ld_row_f32(F.out + m * D, F.lane, h);
#pragma unroll
    for (int j = 0; j < 4; ++j) y0[j] = y0[j] + y1[j];
    const float rs = row_rstd(y0);
#pragma unroll
    for (int j = 0; j < 4; ++j) { h[j] = h[j] + y0[j] * rs * gp[j]; if (poison) h[j] = (f32x4){qnan, qnan, qnan, qnan}; }
    st_row_f32(F.out + m * D, F.lane, h);
}
__device__ __forceinline__ void phase_final(const Args& a, Frame& F, bool poison, int mode, int nskip) {
    const bf16* ys = (const bf16*)(F.ws + WS_YS); const int* tok_slot = (const int*)(F.ws + WS_TAB + TAB_TOKSLOT);
    f32x4 gp[4]; ld_row_f32((const float*)a.in[26], F.lane, gp);
#if MOE_FP8
    if (mode == 0) { const int stride = (F.G - nskip) * NWAVES;
        for (int mi = (F.c - nskip) * NWAVES + F.wave; mi < M; mi += stride) { const size_t m = (size_t)mi; const int s0 = tok_slot[2 * m], s1 = tok_slot[2 * m + 1];
            if (s0 >= TAIL_SLOT0 || s1 >= TAIL_SLOT0) continue;
            final_row(ys, m, s0, s1, gp, F, poison); } }
    else {
        for (int i = 0; i < 16; ++i) { const size_t m = (size_t)(128 * F.c + 16 * F.wave + i); const int s0 = tok_slot[2 * m], s1 = tok_slot[2 * m + 1];
            if (!(s0 >= TAIL_SLOT0 || s1 >= TAIL_SLOT0)) continue;
            final_row(ys, m, s0, s1, gp, F, poison); } }
#else
    for (int i = 0; i < 16; ++i) { const size_t m = (size_t)(128 * F.c + 16 * F.wave + i); final_row(ys, m, tok_slot[2 * m], tok_slot[2 * m + 1], gp, F, poison); }
#endif
}

namespace att {
using bf16x8 = __attribute__((ext_vector_type(8))) short;
using s16x4 = __attribute__((ext_vector_type(4))) short;
using f32x16 = __attribute__((ext_vector_type(16))) float;
using u32x4 = __attribute__((ext_vector_type(4))) unsigned;
typedef LAS const char* lds_cptr;
constexpr int SLOTB = 8192;
constexpr int L_K = 0, L_V = 4 * SLOTB, L_WS = 8 * SLOTB, L_OST = L_WS + 8 * 256, L_FLAG = L_OST + 8 * 4096, L_END = L_FLAG + 64;
static_assert(L_END <= RING_BYTES, "attention LDS map");
#define SBAR() __builtin_amdgcn_sched_barrier(0)
#define WAIT_BAR(N) asm volatile("s_waitcnt vmcnt(" #N ") lgkmcnt(0)\n\ts_barrier" ::: "memory")
#define WAIT_BAR_L() asm volatile("s_waitcnt lgkmcnt(0)\n\ts_barrier" ::: "memory")
__device__ __forceinline__ int crow(int r, int hi) { return (r & 3) + 8 * (r >> 2) + 4 * hi; }
__device__ __forceinline__ void glds16(const void* gsrc, unsigned lds_dst) { unsigned keep;
    asm volatile("s_mov_b32 %0, m0\n\ts_mov_b32 m0, %2\n\ts_nop 0\n\tglobal_load_lds_dwordx4 %1, off\n\ts_mov_b32 m0, %0" : "=&s"(keep) : "v"(gsrc), "s"(lds_dst) : "memory"); }
__device__ __forceinline__ unsigned cvtpk(float lo, float hi) { unsigned r; asm volatile("v_cvt_pk_bf16_f32 %0, %1, %2" : "=v"(r) : "v"(lo), "v"(hi)); return r; }
__device__ __forceinline__ float swap_max(float m) { auto rr = __builtin_amdgcn_permlane32_swap(__float_as_uint(m), __float_as_uint(m), false, false); return fmaxf(__uint_as_float(rr[0]), __uint_as_float(rr[1])); }
__device__ __forceinline__ float swap_sum(float m) { auto rr = __builtin_amdgcn_permlane32_swap(__float_as_uint(m), __float_as_uint(m), false, false); return __uint_as_float(rr[0]) + __uint_as_float(rr[1]); }

struct KV { const bf16* K; const bf16* V; int ld; };
__device__ __forceinline__ void dma_k(const KV& kv, int key0, unsigned lds0, int slot, int wid, int lane) {
    glds16(kv.K + (size_t)(key0 + lane) * kv.ld + wid * 8, (unsigned)__builtin_amdgcn_readfirstlane(lds0 + L_K + slot * SLOTB + wid * 1024)); }
__device__ __forceinline__ void dma_v(const KV& kv, int key0, unsigned lds0, int slot, int wid, int lane) {
    glds16(kv.V + (size_t)(key0 + 16 * (wid & 3) + (lane >> 2)) * kv.ld + (wid >> 2) * 32 + (lane & 3) * 8, (unsigned)__builtin_amdgcn_readfirstlane(lds0 + L_V + slot * SLOTB + wid * 1024)); }
__device__ __forceinline__ void load_q(bf16x8 (&qr)[4], const bf16* Qrow0, int ld, int r32, int hi) {
#pragma unroll
    for (int d0 = 0; d0 < 4; ++d0) qr[d0] = *(const bf16x8*)(Qrow0 + (size_t)r32 * ld + d0 * 16 + hi * 8);
}
__device__ __forceinline__ void qkt(f32x16& p0, f32x16& p1, lds_cptr Kslot, const bf16x8 (&qr)[4], int r32, int hi) {
    const lds_cptr kb = Kslot + hi * 1024 + r32 * 16;
    f32x16 z0 = f32x16{}, z1 = f32x16{};
#pragma unroll
    for (int d0 = 0; d0 < 4; ++d0) {
        const bf16x8 b0 = *(LAS const bf16x8*)(kb + d0 * 2048);
        const bf16x8 b1 = *(LAS const bf16x8*)(kb + d0 * 2048 + 512);
        z0 = __builtin_amdgcn_mfma_f32_32x32x16_bf16(b0, qr[d0], z0, 0, 0, 0); z1 = __builtin_amdgcn_mfma_f32_32x32x16_bf16(b1, qr[d0], z1, 0, 0, 0); }
    p0 = z0; p1 = z1;
}
__device__ __forceinline__ void pv(f32x16 (&o)[2], int vb, bf16x8 pa0, bf16x8 pa1, bf16x8 pa2, bf16x8 pa3) {
#pragma unroll
    for (int d0 = 0; d0 < 2; ++d0) { s16x4 lo[4], hi[4];
#pragma unroll
        for (int ks = 0; ks < 4; ++ks) {
            asm volatile("ds_read_b64_tr_b16 %0,%1 offset:%c2" : "=&v"(lo[ks]) : "v"(vb), "i"(d0 * 4096 + ks * 1024) : "memory");
            asm volatile("ds_read_b64_tr_b16 %0,%1 offset:%c2" : "=&v"(hi[ks]) : "v"(vb), "i"(d0 * 4096 + ks * 1024 + 512) : "memory"); }
        asm volatile("s_waitcnt lgkmcnt(0)" ::: "memory"); SBAR();
#define ATT_PK(k) (bf16x8){lo[k][0], lo[k][1], lo[k][2], lo[k][3], hi[k][0], hi[k][1], hi[k][2], hi[k][3]}
        o[d0] = __builtin_amdgcn_mfma_f32_32x32x16_bf16(pa0, ATT_PK(0), o[d0], 0, 0, 0);
        o[d0] = __builtin_amdgcn_mfma_f32_32x32x16_bf16(pa1, ATT_PK(1), o[d0], 0, 0, 0);
        o[d0] = __builtin_amdgcn_mfma_f32_32x32x16_bf16(pa2, ATT_PK(2), o[d0], 0, 0, 0);
        o[d0] = __builtin_amdgcn_mfma_f32_32x32x16_bf16(pa3, ATT_PK(3), o[d0], 0, 0, 0);
#undef ATT_PK
    }
}
__device__ __forceinline__ void pack_p(const f32x16& p0, const f32x16& p1, bf16x8& a0, bf16x8& a1, bf16x8& a2, bf16x8& a3) {
    u32x4 w0 = (u32x4){cvtpk(p0[0], p0[1]), cvtpk(p0[2], p0[3]), cvtpk(p0[4], p0[5]), cvtpk(p0[6], p0[7])}, w1 = (u32x4){cvtpk(p0[8], p0[9]), cvtpk(p0[10], p0[11]), cvtpk(p0[12], p0[13]), cvtpk(p0[14], p0[15])};
    u32x4 w2 = (u32x4){cvtpk(p1[0], p1[1]), cvtpk(p1[2], p1[3]), cvtpk(p1[4], p1[5]), cvtpk(p1[6], p1[7])}, w3 = (u32x4){cvtpk(p1[8], p1[9]), cvtpk(p1[10], p1[11]), cvtpk(p1[12], p1[13]), cvtpk(p1[14], p1[15])};
    a0 = __builtin_bit_cast(bf16x8, w0); a1 = __builtin_bit_cast(bf16x8, w1); a2 = __builtin_bit_cast(bf16x8, w2); a3 = __builtin_bit_cast(bf16x8, w3);
}
__device__ __forceinline__ void store_o(const f32x16 (&o)[2], float l_row, bool normalize, bf16* Orow0, int ldo, LAS unsigned char* shm, int wid, int lane, int r32, int hi) {
    LAS float* wsf = (LAS float*)(shm + L_WS) + wid * 64;
    float rli[16];
    if (normalize) { if (hi == 0) wsf[32 + r32] = l_row; asm volatile("s_waitcnt lgkmcnt(0)" ::: "memory");
#pragma unroll
        for (int r = 0; r < 16; ++r) rli[r] = __builtin_amdgcn_rcpf(wsf[32 + crow(r, hi)]); }
    else {
#pragma unroll
        for (int r = 0; r < 16; ++r) rli[r] = 1.0f; }
    LAS bf16* stg = (LAS bf16*)(shm + L_OST) + wid * 2048;
#pragma unroll
    for (int r = 0; r < 16; ++r) { const int orow = crow(r, hi);
#pragma unroll
        for (int d0 = 0; d0 < 2; ++d0) stg[orow * 64 + d0 * 32 + r32] = (bf16)f2bf(o[d0][r] * rli[r]); }
    asm volatile("s_waitcnt lgkmcnt(0)" ::: "memory");
#pragma unroll
    for (int i = 0; i < 4; ++i) { const int row = i * 8 + (lane >> 3), ch = lane & 7; const u32x4 v = *(LAS const u32x4*)(stg + row * 64 + ch * 8); *(u32x4*)(Orow0 + (size_t)row * ldo + ch * 8) = v; }
    asm volatile("s_waitcnt lgkmcnt(0)" ::: "memory");
}

template <bool MASK> __device__ __forceinline__ void softmax_task(LAS unsigned char* shm, unsigned lds0, const bf16x8 (&qr)[4], int jlo, int jhi, int tq, float m_init, bool has_sink,
                                                                  f32x16 (&o)[2], float& l_out, int lane, int r32, int hi) {
    const lds_cptr shm3 = (lds_cptr)shm;
    const int vb0 = (int)(lds0 + L_V) + ((lane >> 4) & 1) * 32 + (lane & 3) * 8 + (4 * hi + ((lane & 15) >> 2)) * 64;
    float m = m_init;
    for (int j = jlo; j <= jhi; ++j) { f32x16 p0, p1; qkt(p0, p1, shm3 + L_K + j * SLOTB, qr, r32, hi);
        float a = -INFINITY;
#pragma unroll
        for (int r = 0; r < 16; ++r) { const int kk = 64 * j + crow(r, hi); float s0 = p0[r], s1 = p1[r];
            if (MASK) { if (kk < tq + 1 || kk > tq + 128) s0 = -INFINITY; if (kk + 32 < tq + 1 || kk + 32 > tq + 128) s1 = -INFINITY; }
            a = fmaxf(a, fmaxf(s0, s1)); }
        m = fmaxf(m, a); }
    m = swap_max(m);
    if (!(m > -1e30f)) m = 0.f;
    float l = 0.f; o[0] = f32x16{}; o[1] = f32x16{};
    for (int j = jlo; j <= jhi; ++j) { f32x16 p0, p1; qkt(p0, p1, shm3 + L_K + j * SLOTB, qr, r32, hi);
#pragma unroll
        for (int r = 0; r < 16; ++r) { const int kk = 64 * j + crow(r, hi); float s0 = p0[r], s1 = p1[r];
            if (MASK) { if (kk < tq + 1 || kk > tq + 128) s0 = -INFINITY; if (kk + 32 < tq + 1 || kk + 32 > tq + 128) s1 = -INFINITY; }
            p0[r] = __builtin_amdgcn_exp2f(s0 - m); p1[r] = __builtin_amdgcn_exp2f(s1 - m); l += p0[r] + p1[r]; }
        bf16x8 a0, a1, a2, a3; pack_p(p0, p1, a0, a1, a2, a3);
        pv(o, vb0 + j * SLOTB, a0, a1, a2, a3); }
    l = swap_sum(l);
    if (has_sink) l += __builtin_amdgcn_exp2f(m_init - m);
    l_out = l;
}
__device__ __forceinline__ void swa_phase(Frame& F, const float* sinks) {
    const bf16* P = (const bf16*)(F.ws + WS_PROJ); bf16* O = (bf16*)(F.ws + WS_ATT);
    LAS unsigned char* shm = F.lds + RING_OFF; const unsigned lds0 = (unsigned)(size_t)shm;
    const int lane = F.lane, r32 = lane & 31, hi = lane >> 5, wid = F.wave;
    for (int u = F.c; u < BATCH * NKV0 * 16; u += F.G) {
        const int qb = u & 15, kvh = (u >> 4) % NKV0, b = u / (16 * NKV0);
        const size_t row0 = (size_t)b * SEQ;
        KV kv{P + row0 * N0 + P0_K + kvh * 64, P + row0 * N0 + P0_V + kvh * 64, N0};
        const int jfirst = qb == 0 ? 2 : 0;
        for (int j = jfirst; j < 4; ++j) { dma_k(kv, 128 * qb - 128 + 64 * j, lds0, j, wid, lane); dma_v(kv, 128 * qb - 128 + 64 * j, lds0, j, wid, lane); }
        bf16x8 qa[4], qb2[4];
        const int ta = wid, tb = wid + 8;
        const int ha = 4 * kvh + (ta >> 2), hb = 4 * kvh + (tb >> 2), q0a = 32 * (ta & 3), q0b = 32 * (tb & 3);
        load_q(qa, P + (row0 + 128 * qb + q0a) * N0 + P0_Q + ha * 64, N0, r32, hi);
        load_q(qb2, P + (row0 + 128 * qb + q0b) * N0 + P0_Q + hb * 64, N0, r32, hi);
        WAIT_BAR(0);
        {   const int jlo = (q0a + 1) >> 6, jhi = (q0a + 159) >> 6; f32x16 o[2]; float l;
            softmax_task<true>(shm, lds0, qa, jlo < jfirst ? jfirst : jlo, jhi, q0a + r32, sinks[ha] * LOG2E, true, o, l, lane, r32, hi);
            store_o(o, l, true, O + (row0 + 128 * qb + q0a) * D + ha * 64, D, shm, wid, lane, r32, hi); }
        {   const int jlo = (q0b + 1) >> 6, jhi = (q0b + 159) >> 6; f32x16 o[2]; float l;
            softmax_task<true>(shm, lds0, qb2, jlo < jfirst ? jfirst : jlo, jhi, q0b + r32, sinks[hb] * LOG2E, true, o, l, lane, r32, hi);
            store_o(o, l, true, O + (row0 + 128 * qb + q0b) * D + hb * 64, D, shm, wid, lane, r32, hi); }
        WAIT_BAR(0);
    }
}
__device__ __forceinline__ void cross_phase(Frame& F, const bf16* P, int ldp, int qoff, const bf16* KVm) {
    bf16* O = (bf16*)(F.ws + WS_ATT);
    LAS unsigned char* shm = F.lds + RING_OFF; const unsigned lds0 = (unsigned)(size_t)shm;
    const int lane = F.lane, r32 = lane & 31, hi = lane >> 5, wid = F.wave;
    const int per = (BATCH * NCH * 8 + F.G - 1) / F.G; int loaded = -1;
    for (int u = F.c * per; u < (F.c + 1) * per && u < BATCH * NCH * 8; ++u) {
        const int qb = u & 7, pair = u >> 3, c = pair & 3, b = pair >> 2;
        KV kv{KVm + (size_t)b * MEML * 512 + c * 64, KVm + (size_t)b * MEML * 512 + 256 + c * 64, 512};
        if (pair != loaded) { for (int j = 0; j < 4; ++j) { dma_k(kv, 64 * j, lds0, j, wid, lane); dma_v(kv, 64 * j, lds0, j, wid, lane); } loaded = pair; }
        const size_t qrow = (size_t)b * SEQ + 256 * qb + 32 * wid;
        bf16x8 qr[4]; load_q(qr, P + qrow * ldp + qoff + c * 64, ldp, r32, hi);
        WAIT_BAR(0);
        f32x16 o[2]; float l;
        softmax_task<false>(shm, lds0, qr, 0, 3, 0, -INFINITY, false, o, l, lane, r32, hi);
        store_o(o, l, true, O + qrow * D + NHS * 64 + c * 64, D, shm, wid, lane, r32, hi);
        WAIT_BAR(0);
    }
}
#undef SBAR
}
namespace att {
#define SBAR() __builtin_amdgcn_sched_barrier(0)
constexpr float SB_EXIT = 150.0f;
__device__ __forceinline__ float max0(float a) { float r; asm("v_max_f32_e32 %0, 0, %1" : "=v"(r) : "v"(a)); return r; }
template <bool DIAG> __device__ __forceinline__ void sb_tile(f32x16& p0, f32x16& p1, int key0, int t, float& R, int hi) {
    f32x16 s0, s1;
#pragma unroll
    for (int r = 0; r < 16; ++r) { const float z = p0[r]; float sp = max0(z) + __builtin_amdgcn_logf(1.0f + __builtin_amdgcn_exp2f(-fabsf(z))); if (DIAG && key0 + crow(r, hi) >= t) sp = 0.f; s0[r] = sp; }
    SBAR();
#pragma unroll
    for (int r = 0; r < 16; ++r) { const float z = p1[r]; float sp = max0(z) + __builtin_amdgcn_logf(1.0f + __builtin_amdgcn_exp2f(-fabsf(z))); if (DIAG && key0 + 32 + crow(r, hi) >= t) sp = 0.f; s1[r] = sp; }
    SBAR();
    float G[16];
#pragma unroll
    for (int i = 0; i < 4; ++i) {
        const float g0 = (s0[4 * i] + s0[4 * i + 1]) + (s0[4 * i + 2] + s0[4 * i + 3]), g1 = (s1[4 * i] + s1[4 * i + 1]) + (s1[4 * i + 2] + s1[4 * i + 3]);
        auto r0 = __builtin_amdgcn_permlane32_swap(__float_as_uint(g0), __float_as_uint(g0), false, false); G[2 * i] = __uint_as_float(r0[0]); G[2 * i + 1] = __uint_as_float(r0[1]);
        auto r1 = __builtin_amdgcn_permlane32_swap(__float_as_uint(g1), __float_as_uint(g1), false, false); G[8 + 2 * i] = __uint_as_float(r1[0]); G[8 + 2 * i + 1] = __uint_as_float(r1[1]); }
    float E[16]; E[15] = R;
#pragma unroll
    for (int g = 14; g >= 0; --g) E[g] = E[g + 1] + G[g + 1];
    R = E[0] + G[0];
    SBAR();
#pragma unroll
    for (int i = 0; i < 4; ++i) {
        { float e = hi ? E[2 * i + 1] : E[2 * i];
#pragma unroll
          for (int j = 3; j >= 0; --j) { e += s0[4 * i + j]; float w = __builtin_amdgcn_exp2f(p0[4 * i + j] - e); if (DIAG && key0 + crow(4 * i + j, hi) >= t) w = 0.f; p0[4 * i + j] = w; } }
        { float e = hi ? E[8 + 2 * i + 1] : E[8 + 2 * i];
#pragma unroll
          for (int j = 3; j >= 0; --j) { e += s1[4 * i + j]; float w = __builtin_amdgcn_exp2f(p1[4 * i + j] - e); if (DIAG && key0 + 32 + crow(4 * i + j, hi) >= t) w = 0.f; p1[4 * i + j] = w; } }
    }
}
__device__ __forceinline__ void sb_unit(Frame& F, int b, int h, int qb) {
    const bf16* P = (const bf16*)(F.ws + WS_PROJ); bf16* O = (bf16*)(F.ws + WS_ATT);
    LAS unsigned char* shm = F.lds + RING_OFF; const unsigned lds0 = (unsigned)(size_t)shm; const lds_cptr shm3 = (lds_cptr)shm;
    const int lane = F.lane, r32 = lane & 31, hi = lane >> 5, wid = F.wave;
    const size_t row0 = (size_t)b * SEQ;
    KV kv{P + row0 * N1 + P1_K + h * 64, P + row0 * N1 + P1_V + h * 64, N1};
    const int NT = 4 * qb + 4, T0 = 256 * qb + 32 * wid, t = T0 + r32;
    const int vb0 = (int)(lds0 + L_V) + ((lane >> 4) & 1) * 32 + (lane & 3) * 8 + (4 * hi + ((lane & 15) >> 2)) * 64;
    LAS unsigned* flag = (LAS unsigned*)(shm + L_FLAG);
    dma_k(kv, 64 * (NT - 1), lds0, 0, wid, lane); dma_v(kv, 64 * (NT - 1), lds0, 0, wid, lane);
    bf16x8 qr[4]; load_q(qr, P + (row0 + T0) * N1 + P1_Q + h * 64, N1, r32, hi);
    f32x16 o[2]; o[0] = f32x16{}; o[1] = f32x16{};
    float R = 0.f; bool mydone = false;
    for (int i = 0; i < NT; ++i) {
        const int kt = NT - 1 - i, sl = i & 1;
        if (i + 1 < NT) { dma_k(kv, 64 * (kt - 1), lds0, sl ^ 1, wid, lane); dma_v(kv, 64 * (kt - 1), lds0, sl ^ 1, wid, lane); WAIT_BAR(2); }
        else WAIT_BAR(0);
        if (64 * kt <= T0 + 30 && !mydone) {
            f32x16 p0, p1; qkt(p0, p1, shm3 + L_K + sl * SLOTB, qr, r32, hi);
            if (kt >= 4 * qb) sb_tile<true>(p0, p1, 64 * kt, t, R, hi); else sb_tile<false>(p0, p1, 64 * kt, t, R, hi);
            bf16x8 a0, a1, a2, a3; pack_p(p0, p1, a0, a1, a2, a3);
            pv(o, vb0 + sl * SLOTB, a0, a1, a2, a3);
            mydone = __all(R >= SB_EXIT) != 0;
        }
        if (lane == 0) flag[wid] = mydone ? 1u : 0u;
        WAIT_BAR_L();
        unsigned all = 1u;
#pragma unroll
        for (int w = 0; w < 8; ++w) all &= flag[w];
        if (__builtin_amdgcn_readfirstlane(all) != 0u) break;
        asm volatile("s_waitcnt lgkmcnt(0)" ::: "memory");
    }
    WAIT_BAR(0);
    store_o(o, 1.0f, false, O + (row0 + T0) * D + h * 64, D, shm, wid, lane, r32, hi);
}
__device__ __forceinline__ void sb_phase(Frame& F) {
    for (int k = 0; k < 6; ++k) {
        const int p = 3 * F.c + (k >> 1); if (p >= BATCH * NHS * 4) break;
        const int bh = p >> 2, s = p & 3, qb = (k & 1) ? 7 - s : s;
        sb_unit(F, bh / NHS, bh % NHS, qb);
    }
}
#undef SBAR
}

__global__ void __launch_bounds__(NWAVES * 64, 2) fwd_kernel(Args args) {
    extern __shared__ __attribute__((aligned(16))) unsigned char lds[];
    Frame F;
    F.lds = (LAS unsigned char*)lds; F.MISC = (volatile LAS unsigned*)(F.lds + MISC_OFF);
    F.tid = threadIdx.x; F.lane = F.tid & 63; F.wave = __builtin_amdgcn_readfirstlane(F.tid >> 6);
    F.G = gridDim.x; F.c = blockIdx.x; F.ws = args.ws; F.out = args.out; F.ctl = (gu32*)(args.ws + WS_CTL);
    for (int u = F.tid; u < (LDS_BYTES - LDSCTL_OFF) / 4; u += NWAVES * 64) ((LAS unsigned*)(F.lds + LDSCTL_OFF))[u] = 0u;
    __syncthreads();
    XcdBarrier bar; bar.bar = (unsigned*)(F.ctl + CW_BAR) + args.li * XCD_BAR_WORDS; bar.x = 0; bar.st = nullptr;
    if (!MK_PER_PHASE) bar = xcd_barrier_post((unsigned*)(F.ctl + CW_BAR) + args.li * XCD_BAR_WORDS, F.MISC + 8);
    const int lo = args.ph_lo, hi = args.ph_hi;
#define IN(k) (lo <= (k) && (k) < hi)
#define SEAM(k) do { if (IN(k) && IN((k) + 1)) xcd_barrier(bar); } while (0)
    unsigned char* const ws = args.ws;
    LAS unsigned char* const ring = F.lds + RING_OFF;

    if (IN(0)) { refresh_ids(F); p0_prologue(args, F); SEAM(0); }
    if (IN(1)) {
        pg8::Gemm g{(const bf16*)(ws + WS_XN), (const bf16*)(ws + WS_W0IN), 0, 0, PROJ0_I8 ? D / 2 : D}; pg8::Proj0Order S; S.init(F.G, F.c);
        pg8::EpiProj0 E{(bf16*)(ws + WS_PROJ), (bf16*)(ws + WS_MEMKV), (const float*)(ws + WS_ROPE), (const float*)(ws + WS_TAB + TAB_ROWSC0), (const float*)(ws + WS_TAB + TAB_CS0)};
        pg8::gemm_phase<pg8::EpiProj0, pg8::Proj0Order, true, true, PROJ0_I8 ? 2 : 0>(ring, g, S, E, F.wave);
        SEAM(1);
    }
    if (IN(2)) { refresh_ids(F);
        att::swa_phase(F, (const float*)args.in[7]);
        att::cross_phase(F, (const bf16*)(ws + WS_PROJ), N0, P0_QC, (const bf16*)(ws + WS_MEMKV));
        SEAM(2); }
    if (IN(3)) {
        pg8::Gemm g{(const bf16*)(ws + WS_ATT), (const bf16*)(ws + WS_W0OUT), 0, 0, D}; pg8::StaticOrder S; S.init(M, D, F.G, F.c);
        pg8::EpiPlain E{(bf16*)(ws + WS_MIX), D, 1.0f};
        pg8::gemm_phase<pg8::EpiPlain, pg8::StaticOrder, true, true>(ring, g, S, E, F.wave);
        SEAM(3);
    }
    if (IN(4)) { refresh_ids(F);
#if FFN0_MODE == 2
        {
            LAS float* scr = (LAS float*)(F.lds + RING_OFF + F.wave * 16384); const int gw = F.c * NWAVES + F.wave, NGW = F.G * NWAVES;
            const unsigned* cmax = (const unsigned*)(F.ctl + CW_CMAX);
            for (int it = gw; it < 8 * 224; it += NGW) transpose_item<2>(MapGUq{(const float*)args.in[11], (const float*)args.in[12], cmax}, D, ws + WS_W0GU, 224, scr, it, F.lane);
            float* csg = (float*)(ws + WS_TAB + TAB_CSG);
            for (int i = F.c * (NWAVES * 64) + F.tid; i < 2 * FF; i += F.G * NWAVES * 64) { const float am = __uint_as_float(__hip_atomic_load(cmax + i, RLX_AGENT)); (i < FF ? csg : (float*)(ws + WS_TAB + TAB_CSU) - FF)[i] = am * (1.0f / 127.0f); }
            __syncthreads(); }
#endif
        phase_norm_res<FFN0_MODE>(F, (const bf16*)(ws + WS_MIX), (const float*)args.in[0], (const float*)args.in[9], (const float*)args.in[10], (bf16*)(ws + WS_XN), (float*)(ws + WS_TAB + TAB_ROWSC)); SEAM(4); }
    if (IN(5)) {
#if FFN0_MODE == 2
        pg8::Gemm g{(const bf16*)(ws + WS_XN), (const bf16*)(ws + WS_W0GU), 0, 0, D / 2}; pg8::StaticOrder S; S.init(M, 2 * FF, F.G, F.c);
        pg8::EpiSwigluI8 E{(bf16*)(ws + WS_HID), (const float*)(ws + WS_TAB + TAB_ROWSC), (const float*)(ws + WS_TAB + TAB_CSG), (const float*)(ws + WS_TAB + TAB_CSU), H_SCALE};
        pg8::gemm_phase<pg8::EpiSwigluI8, pg8::StaticOrder, true, true, 2>(ring, g, S, E, F.wave);
#else
        pg8::Gemm g{(const bf16*)(ws + WS_XN), (const bf16*)(ws + WS_W0GU), 0, 0, D}; pg8::StaticOrder S; S.init(M, 2 * FF, F.G, F.c);
        pg8::EpiSwiglu E{(bf16*)(ws + WS_HID)};
        pg8::gemm_phase<pg8::EpiSwiglu, pg8::StaticOrder, true, true>(ring, g, S, E, F.wave);
#endif
        SEAM(5);
    }
    if (IN(6)) {
#if DOWN0_FP8 && FFN0_MODE == 2
        pg8::Gemm g{(const bf16*)(ws + WS_HID), (const bf16*)(ws + WS_W0DOWN), 0, 0, FF / 2}; pg8::StaticOrder S; S.init(M, D, F.G, F.c);
        pg8::EpiPlain E{(bf16*)(ws + WS_MIX), D, 1.0f / (H_SCALE * WDN_SCALE)};
        pg8::gemm_phase<pg8::EpiPlain, pg8::StaticOrder, true, true, 1>(ring, g, S, E, F.wave);
#else
        pg8::Gemm g{(const bf16*)(ws + WS_HID), (const bf16*)(ws + WS_W0DOWN), 0, 0, FF}; pg8::StaticOrder S; S.init(M, D, F.G, F.c);
        pg8::EpiPlain E{(bf16*)(ws + WS_MIX), D, 1.0f};
        pg8::gemm_phase<pg8::EpiPlain, pg8::StaticOrder, true, true>(ring, g, S, E, F.wave);
#endif
        SEAM(6);
    }
    if (IN(7)) { refresh_ids(F);
#if PROJ1_I8
        {
            LAS float* scr = (LAS float*)(F.lds + RING_OFF + F.wave * 16384); const int gw = F.c * NWAVES + F.wave, NGW = F.G * NWAVES;
            const unsigned* cmax = (const unsigned*)(F.ctl + CW_CMAX1);
            for (int it = gw; it < 8 * 80; it += NGW) transpose_item<2>(MapIdentQ{(const float*)args.in[17], N1, cmax}, D, ws + WS_W1IN, 80, scr, it, F.lane);
            float* cs1 = (float*)(ws + WS_TAB + TAB_CS1);
            for (int i = F.c * (NWAVES * 64) + F.tid; i < N1; i += F.G * NWAVES * 64) { const float am = __uint_as_float(__hip_atomic_load(cmax + i, RLX_AGENT)); cs1[i] = am * (1.0f / 127.0f) * ((i < 768 || i >= 2304) ? QSCALE : 1.0f); }
            __syncthreads(); }
        phase_norm_res<2>(F, (const bf16*)(ws + WS_MIX), F.out, (const float*)args.in[14], (const float*)args.in[15], (bf16*)(ws + WS_XN), (float*)(ws + WS_TAB + TAB_ROWSC)); SEAM(7); }
#else
        phase_norm_res<0>(F, (const bf16*)(ws + WS_MIX), F.out, (const float*)args.in[14], (const float*)args.in[15], (bf16*)(ws + WS_XN), nullptr); SEAM(7); }
#endif
    if (IN(8)) {
#if PROJ1_I8
        pg8::Gemm g{(const bf16*)(ws + WS_XN), (const bf16*)(ws + WS_W1IN), 0, 0, D / 2}; pg8::StaticOrder S; S.init(M, N1, F.G, F.c);
        pg8::EpiPlainI8 E{(bf16*)(ws + WS_PROJ), N1, (const float*)(ws + WS_TAB + TAB_ROWSC), (const float*)(ws + WS_TAB + TAB_CS1)};
        pg8::gemm_phase<pg8::EpiPlainI8, pg8::StaticOrder, true, true, 2>(ring, g, S, E, F.wave);
#else
        pg8::Gemm g{(const bf16*)(ws + WS_XN), (const bf16*)(ws + WS_W1IN), 0, 0, D}; pg8::StaticOrder S; S.init(M, N1, F.G, F.c);
        pg8::EpiPlain E{(bf16*)(ws + WS_PROJ), N1, 1.0f};
        pg8::gemm_phase<pg8::EpiPlain, pg8::StaticOrder, true, true>(ring, g, S, E, F.wave);
#endif
        SEAM(8);
    }
    if (IN(9)) { refresh_ids(F);
        att::sb_phase(F);
        att::cross_phase(F, (const bf16*)(ws + WS_PROJ), N1, P1_QC, (const bf16*)(ws + WS_MEMKV) + (size_t)MEMR * 512);
        SEAM(9); }
    if (IN(10)) {
        pg8::Gemm g{(const bf16*)(ws + WS_ATT), (const bf16*)(ws + WS_W1OUT), 0, 0, D}; pg8::StaticOrder S; S.init(M, D, F.G, F.c);
        pg8::EpiPlain E{(bf16*)(ws + WS_MIX), D, 1.0f};
        pg8::gemm_phase<pg8::EpiPlain, pg8::StaticOrder, true, true>(ring, g, S, E, F.wave);
        SEAM(10);
    }
    if (IN(11)) { refresh_ids(F); phase_route(args, F); SEAM(11); }
    if (IN(12)) { refresh_ids(F); phase_permute(args, F); SEAM(12); }
#if MOE_FP8
    if (IN(13)) { refresh_ids(F); const int T = build_expert_table(F);
        pg8::Gemm g{(const bf16*)(ws + WS_XS), (const bf16*)(ws + WS_W1GU), 0, 0, D / 2}; pg8::MoeOrder<false> S; S.init(T, 2 * FF / 256, 0, (const LAS unsigned char*)(F.lds + ETAB_OFF), F.G, F.c);
        pg8::EpiSwiglu8 E{ws + WS_HID8, 1.0f / (XS_SCALE * WGU_SCALE), H_SCALE};
        pg8::gemm_phase<pg8::EpiSwiglu8, pg8::MoeOrder<false>, true, true, 1>(ring, g, S, E, F.wave);
        SEAM(13); }
    if (IN(14)) { refresh_ids(F); const int T = build_expert_table(F);
        pg8::Gemm g{(const bf16*)(ws + WS_HID8), (const bf16*)(ws + WS_W1DOWN), 0, 0, FF / 2}; pg8::MoeOrder<true> S; S.init(T < TAIL_TILE0 ? T : TAIL_TILE0, D / 256, 0, (const LAS unsigned char*)(F.lds + ETAB_OFF), F.G, F.c);
        pg8::EpiMoeDown E{(bf16*)(ws + WS_YS), (const float*)(ws + WS_TAB + TAB_SLOTW), 1.0f / (H_SCALE * WDN_SCALE)};
        pg8::gemm_phase<pg8::EpiMoeDown, pg8::MoeOrder<true>, true, true, 1>(ring, g, S, E, F.wave);
        SEAM(14); }
    if (IN(15)) { refresh_ids(F); const int T = build_expert_table(F); const int ntail = T > TAIL_TILE0 ? T - TAIL_TILE0 : 0, nu = ntail * (D / 256);
        bool poison = false;
        if (!MK_PER_PHASE) for (int li = 0; li <= args.li; ++li) poison |= __hip_atomic_load((unsigned*)(F.ctl + CW_BAR) + li * XCD_BAR_WORDS + XB_TMO, RLX_AGENT) != 0u;
        if (F.c < nu) {
            pg8::Gemm g{(const bf16*)(ws + WS_HID8), (const bf16*)(ws + WS_W1DOWN), 0, 0, FF / 2}; pg8::MoeOrder<true> S; S.init(ntail, D / 256, TAIL_TILE0, (const LAS unsigned char*)(F.lds + ETAB_OFF), F.G, F.c, TAIL_TILE0);
            pg8::EpiMoeDown E{(bf16*)(ws + WS_YS), (const float*)(ws + WS_TAB + TAB_SLOTW), 1.0f / (H_SCALE * WDN_SCALE)};
            pg8::gemm_phase<pg8::EpiMoeDown, pg8::MoeOrder<true>, true, true, 1>(ring, g, S, E, F.wave); }
        else phase_final(args, F, poison, 0, nu);
        SEAM(15); }
#else
#define MOE_CHUNK(ck) \
    if (IN(13 + 2 * (ck))) { refresh_ids(F); const int T = build_expert_table(F); const int t0 = (ck) * CHT; int nM = T - t0; nM = nM < 0 ? 0 : (nM > CHT ? CHT : nM); \
        pg8::Gemm g{(const bf16*)(ws + WS_XS), (const bf16*)(ws + WS_W1GU), 0, 0, D}; pg8::MoeOrder<false> S; S.init(nM, 2 * FF / 256, t0, (const LAS unsigned char*)(F.lds + ETAB_OFF), F.G, F.c); \
        pg8::EpiSwiglu E{(bf16*)(ws + WS_HID)}; \
        pg8::gemm_phase<pg8::EpiSwiglu, pg8::MoeOrder<false>, true, true>(ring, g, S, E, F.wave); \
        SEAM(13 + 2 * (ck)); } \
    if (IN(14 + 2 * (ck))) { refresh_ids(F); const int T = build_expert_table(F); const int t0 = (ck) * CHT; int nM = T - t0; nM = nM < 0 ? 0 : (nM > CHT ? CHT : nM); \
        pg8::Gemm g{(const bf16*)(ws + WS_HID), (const bf16*)(ws + WS_W1DOWN), 0, 0, FF}; pg8::MoeOrder<true> S; S.init(nM, D / 256, t0, (const LAS unsigned char*)(F.lds + ETAB_OFF), F.G, F.c); \
        pg8::EpiMoeDown E{(bf16*)(ws + WS_YS), (const float*)(ws + WS_TAB + TAB_SLOTW), 1.0f}; \
        pg8::gemm_phase<pg8::EpiMoeDown, pg8::MoeOrder<true>, true, true>(ring, g, S, E, F.wave); \
        SEAM(14 + 2 * (ck)); }
    MOE_CHUNK(0)
    MOE_CHUNK(1)
    MOE_CHUNK(2)
#undef MOE_CHUNK
#endif
    if (IN(PH_FINAL)) { refresh_ids(F);
        bool poison = false;
        if (!MK_PER_PHASE) for (int li = 0; li <= args.li; ++li) poison |= __hip_atomic_load((unsigned*)(F.ctl + CW_BAR) + li * XCD_BAR_WORDS + XB_TMO, RLX_AGENT) != 0u;
        phase_final(args, F, poison, 1, 0);
    }
#undef IN
#undef SEAM
#undef MOE_CHUNK
}

extern "C" void kernel_launch(void* const* d_in, const int* in_sizes, int n_in, void* d_out, int out_size, void* d_ws, size_t ws_size, hipStream_t stream) {
    static int grid = 0;
    if (grid == 0) {
        if (n_in != 27 || in_sizes[0] != M * D || out_size != M * D || ws_size < WS_END) { fprintf(stderr, "kernel_launch: shape / workspace mismatch (n_in %d, ws %zu); nothing launched\n", n_in, ws_size); grid = -1; return; }
        int dev = 0, cus = 0;
        if (hipGetDevice(&dev) != hipSuccess || hipDeviceGetAttribute(&cus, hipDeviceAttributeMultiprocessorCount, dev) != hipSuccess) { grid = -1; return; }
        if (hipFuncSetAttribute((const void*)fwd_kernel, hipFuncAttributeMaxDynamicSharedMemorySize, LDS_BYTES) != hipSuccess) { grid = -1; return; }
        (void)hipGetLastError();
        if (cus != 256) { fprintf(stderr, "kernel_launch: built for 256 CUs, found %d; nothing launched\n", cus); grid = -1; return; }
        grid = 256;
    }
    if (grid < 0) return;
    if (hipMemsetAsync((char*)d_ws + WS_CTL, 0, CTL_ZERO_BYTES, stream) != hipSuccess) return;
    Args a{};
    for (int i = 0; i < 27; ++i) a.in[i] = d_in[i];
    a.out = (float*)d_out; a.ws = (unsigned char*)d_ws;
#if MK_PER_PHASE
    for (int p = 0; p < NPHASE; ++p) { a.ph_lo = p; a.ph_hi = p + 1; a.li = 0; hipLaunchKernelGGL(fwd_kernel, dim3(grid), dim3(NWAVES * 64), LDS_BYTES, stream, a); }
#elif defined(PROBE_SEGS)
    const int segs[][2] = {PROBE_SEGS};
    for (int i = 0; i < (int)(sizeof(segs) / sizeof(segs[0])); ++i) { a.ph_lo = segs[i][0]; a.ph_hi = segs[i][1]; a.li = i; hipLaunchKernelGGL(fwd_kernel, dim3(grid), dim3(NWAVES * 64), LDS_BYTES, stream, a); }
#else
    a.ph_lo = 0; a.ph_hi = NPHASE; a.li = 0;
    hipLaunchKernelGGL(fwd_kernel, dim3(grid), dim3(NWAVES * 64), LDS_BYTES, stream, a);
#endif
}
```

```cpp
#include <hip/hip_runtime.h>
#include <cstdio>
#include <cstdint>

#ifndef MOE_FP8
#define MOE_FP8 1
#endif
#ifndef FFN0_MODE
#define FFN0_MODE 2
#endif
#ifndef DOWN0_FP8
#define DOWN0_FP8 0
#endif
#ifndef PROJ1_I8
#define PROJ1_I8 1
#endif
#ifndef PROJ0_I8
#define PROJ0_I8 0
#endif
#ifndef MEMKV_EARLY
#define MEMKV_EARLY 1
#endif
#ifndef MK_PER_PHASE
#define MK_PER_PHASE 0
#endif

namespace pg8 {
#define PG8_LAS __attribute__((address_space(3)))
typedef unsigned short bf16_t;
typedef short bf16x8 __attribute__((ext_vector_type(8)));
typedef float f32x4 __attribute__((ext_vector_type(4)));
typedef unsigned u32x4 __attribute__((ext_vector_type(4)));
constexpr int BM = 256, BK = 64, HALF = 128, HTB = HALF * BK * 2  , STAGE_BYTES = 8 * HTB, NXCD = 8, WGM = 8;

__host__ __device__ __forceinline__ int lds_byte(int r, int c) { const int st = (r >> 4) * 2 + (c >> 5), rr = r & 15, cc = c & 31, ob = rr * 64 + cc * 2; return st * 1024 + (ob ^ (((ob >> 9) & 1) << 5)); }
__host__ __device__ __forceinline__ void stage_rc(int b, int& R, int& C) { const int st = b / 1024, sb = b % 1024, swz = sb ^ (((sb >> 9) & 1) << 5); R = (st >> 1) * 16 + swz / 64; C = (st & 1) * 32 + (swz % 64) / 2; }
__host__ __device__ __forceinline__ int perm32(int rho) { const int n = rho >> 4, i = rho & 15; return 8 * (i >> 2) + 4 * n + (i & 3); }

struct Unit { int pm, pn, om, on; };
struct Gemm { const bf16_t* A; const bf16_t* Bt; int M, N, K; };

struct StaticOrder {
    int nM, nN, nwg, G, c;
    __host__ __device__ void init(int M, int N, int G_, int c_) { nM = M / BM; nN = N / BM; nwg = nM * nN; G = G_; c = c_; }
    __host__ __device__ bool tile(int i, int& tm, int& tn) const {
        const long L = (long)i * G + c; if (L >= nwg) return false;
        int wgid = (int)L; { const int q = nwg / NXCD, r = nwg % NXCD, xcd = wgid % NXCD, off = wgid / NXCD; wgid = (xcd < r ? xcd * (q + 1) : r * (q + 1) + (xcd - r) * q) + off; }
        const int nig = WGM * nN, gid = wgid / nig, fm = gid * WGM, gsz = (nM - fm) < WGM ? (nM - fm) : WGM;
        tm = fm + ((wgid % nig) % gsz); tn = (wgid % nig) / gsz; return true;
    }
    __host__ __device__ bool next(int i, Unit& u) const { int tm, tn; if (!tile(i, tm, tn)) return false; u.pm = tm; u.pn = tn; u.om = tm; u.on = tn; return true; }
    __device__ __forceinline__ void a_ready(const Unit&) const {}
    __device__ __forceinline__ void done(const Unit&) const {}
};
struct Proj0Order {
    StaticOrder so; int nmain;
    __device__ void init(int G_, int c_) { so.init(32768, 1536, G_, c_); nmain = so.nwg; }
    __device__ bool next(int i, Unit& u) const {
        const long L = (long)i * so.G + so.c;
        if (L < nmain) return so.next(i, u);
        const int x = (int)(L - nmain); if (x >= 64) return false;
        const int w = x >> 5, y = x & 31;
        u.pm = 128 + 16 * w + (y >> 1); u.pn = 6 + 2 * w + (y & 1); u.om = u.pm; u.on = u.pn; return true;
    }
    __device__ __forceinline__ void a_ready(const Unit&) const {}
    __device__ __forceinline__ void done(const Unit&) const {}
};
struct MemOrder {
    int c;
    __device__ bool next(int i, Unit& u) const { if (i != 0 || c >= 64) return false; const int w = c >> 5, y = c & 31; u.pm = 128 + 16 * w + (y >> 1); u.pn = 6 + 2 * w + (y & 1); u.om = u.pm; u.on = u.pn; return true; }
    __device__ __forceinline__ void a_ready(const Unit&) const {}
    __device__ __forceinline__ void done(const Unit&) const {}
};
template <bool A_LOCAL> struct MoeOrder {
    StaticOrder so; int t0, a_add; const PG8_LAS unsigned char* tab;
    __device__ void init(int nM, int nN, int t0_, const PG8_LAS unsigned char* tab_, int G_, int c_, int a_add_ = 0) { so.init(nM * BM, nN * BM, G_, c_); t0 = t0_; tab = tab_; a_add = a_add_; }
    __device__ bool next(int i, Unit& u) const {
        int tm, tn; if (so.nwg <= 0 || !so.tile(i, tm, tn)) return false;
        const int gt = t0 + tm, e = (int)tab[gt];
        u.pm = (A_LOCAL ? tm : gt) + a_add; u.pn = e * so.nN + tn; u.om = A_LOCAL ? gt : tm; u.on = tn; return true;
    }
    __device__ __forceinline__ void a_ready(const Unit&) const {}
    __device__ __forceinline__ void done(const Unit&) const {}
};

__device__ __forceinline__ unsigned cvt_pk_bf16(float lo, float hi) { unsigned r; asm volatile("v_cvt_pk_bf16_f32 %0, %1, %2" : "=v"(r) : "v"(lo), "v"(hi)); return r; }
__device__ __forceinline__ u32x4 pack8(const f32x4 a, const f32x4 b) { u32x4 w; w.x = cvt_pk_bf16(a[0], a[1]); w.y = cvt_pk_bf16(a[2], a[3]); w.z = cvt_pk_bf16(b[0], b[1]); w.w = cvt_pk_bf16(b[2], b[3]); return w; }

struct EpiPlain {
    static constexpr bool PERM = true, AFTER_DRAIN = false;
    bf16_t* O; int ldc; float ascale;
    __device__ __forceinline__ void operator()(const f32x4 (&acc)[2][2][4][2], const Unit& u, int wr, int wc, int fr, int fq) const {
        const int row0 = u.om * BM + wr * 64 + fr, col0 = u.on * BM + wc * 32 + 8 * fq;
#pragma unroll
        for (int ai = 0; ai < 2; ++ai)
#pragma unroll
            for (int m = 0; m < 4; ++m) { bf16_t* rowp = O + (size_t)(row0 + ai * HALF + m * 16) * ldc + col0;
#pragma unroll
                for (int bj = 0; bj < 2; ++bj) *(u32x4*)(rowp + bj * HALF) = pack8(acc[ai][bj][m][0] * ascale, acc[ai][bj][m][1] * ascale); }
    }
};
struct EpiProj0 {
    static constexpr bool PERM = true, AFTER_DRAIN = false;
    bf16_t* P; bf16_t* KV; const float* rope;
    const float* rowscale; const float* colscale;
    __device__ __forceinline__ void operator()(const f32x4 (&acc)[2][2][4][2], const Unit& u, int wr, int wc, int fr, int fq) const {
        bf16_t* base; int ldc, rowt, colt; bool do_rope;
        if (u.pm < 128) { base = P; ldc = 1536; rowt = u.pm; colt = u.pn; do_rope = u.pn < 4; }
        else { const int w = (u.pm >= 144) ? 1 : 0; base = KV + (size_t)w * 4096 * 512; ldc = 512; rowt = u.pm - 128 - 16 * w; colt = u.pn - 6 - 2 * w; do_rope = false; }
        const int row0 = rowt * BM + wr * 64 + fr, col0 = colt * BM + wc * 32 + 8 * fq, dl = 16 * (wc & 1) + 4 * fq;
        f32x4 csc[2][2];
        if (PROJ0_I8) {
#pragma unroll
            for (int bj = 0; bj < 2; ++bj) { csc[bj][0] = *(const f32x4*)(colscale + u.pn * BM + wc * 32 + 8 * fq + bj * HALF); csc[bj][1] = *(const f32x4*)(colscale + u.pn * BM + wc * 32 + 8 * fq + bj * HALF + 4); } }
#pragma unroll
        for (int ai = 0; ai < 2; ++ai)
#pragma unroll
            for (int m = 0; m < 4; ++m) { const int r = row0 + ai * HALF + m * 16; bf16_t* rowp = base + (size_t)r * ldc + col0;
                float rsc = 1.f; if (PROJ0_I8) rsc = rowscale[u.pm * BM + wr * 64 + fr + ai * HALF + m * 16];
                f32x4 cs = (f32x4){1.f, 1.f, 1.f, 1.f}, sn = (f32x4){0.f, 0.f, 0.f, 0.f};
                if (do_rope) { cs = *(const f32x4*)(rope + (size_t)r * 64 + dl); sn = *(const f32x4*)(rope + (size_t)r * 64 + 32 + dl); }
#pragma unroll
                for (int bj = 0; bj < 2; ++bj) { f32x4 v0 = acc[ai][bj][m][0], v1 = acc[ai][bj][m][1];
                    if (PROJ0_I8) { typedef int i32x4 __attribute__((ext_vector_type(4))); const i32x4 a0 = __builtin_bit_cast(i32x4, v0), a1 = __builtin_bit_cast(i32x4, v1);
                        v0 = (f32x4){(float)a0[0], (float)a0[1], (float)a0[2], (float)a0[3]} * (csc[bj][0] * rsc); v1 = (f32x4){(float)a1[0], (float)a1[1], (float)a1[2], (float)a1[3]} * (csc[bj][1] * rsc); }
                    const f32x4 o0 = v0 * cs - v1 * sn, o1 = v1 * cs + v0 * sn;
                    *(u32x4*)(rowp + bj * HALF) = pack8(o0, o1); } }
    }
};
__device__ __forceinline__ float silu_mul(float g, float u) { return g * __builtin_amdgcn_rcpf(1.0f + __builtin_amdgcn_exp2f(-1.4426950408889634f * g)) * u; }
typedef float f32x2 __attribute__((ext_vector_type(2)));
__device__ __forceinline__ f32x2 sig_mul2(f32x2 tg, f32x2 pu) { f32x2 e; e.x = __builtin_amdgcn_exp2f(tg.x); e.y = __builtin_amdgcn_exp2f(tg.y); const f32x2 d = e + 1.0f; f32x2 r; r.x = __builtin_amdgcn_rcpf(d.x); r.y = __builtin_amdgcn_rcpf(d.y); return pu * r; }
struct EpiSwiglu {
    static constexpr bool PERM = true, AFTER_DRAIN = false;
    bf16_t* H;
    __device__ __forceinline__ void operator()(const f32x4 (&acc)[2][2][4][2], const Unit& u, int wr, int wc, int fr, int fq) const {
        const int row0 = u.om * BM + wr * 64 + fr, col0 = u.on * HALF + wc * 32 + 8 * fq;
#pragma unroll
        for (int ai = 0; ai < 2; ++ai)
#pragma unroll
            for (int m = 0; m < 4; ++m) { bf16_t* rowp = H + (size_t)(row0 + ai * HALF + m * 16) * 3584 + col0;
                f32x4 h0, h1;
#pragma unroll
                for (int j = 0; j < 4; ++j) { h0[j] = silu_mul(acc[ai][0][m][0][j], acc[ai][1][m][0][j]); h1[j] = silu_mul(acc[ai][0][m][1][j], acc[ai][1][m][1][j]); }
                *(u32x4*)rowp = pack8(h0, h1); }
    }
};
__device__ __forceinline__ unsigned pk4_fp8(float a, float b, float c, float d) {
    a = __builtin_amdgcn_fmed3f(a, -448.f, 448.f); b = __builtin_amdgcn_fmed3f(b, -448.f, 448.f); c = __builtin_amdgcn_fmed3f(c, -448.f, 448.f); d = __builtin_amdgcn_fmed3f(d, -448.f, 448.f);
    int w = 0; w = __builtin_amdgcn_cvt_pk_fp8_f32(a, b, w, false); w = __builtin_amdgcn_cvt_pk_fp8_f32(c, d, w, true); return (unsigned)w; }
struct EpiSwiglu8 {
    static constexpr bool PERM = true, AFTER_DRAIN = false;
    unsigned char* H; float ascale, hscale;
    __device__ __forceinline__ void operator()(const f32x4 (&acc)[2][2][4][2], const Unit& u, int wr, int wc, int fr, int fq) const {
        typedef unsigned u32x2 __attribute__((ext_vector_type(2)));
        const int row0 = u.om * BM + wr * 64 + fr, col0 = u.on * HALF + wc * 32 + 8 * fq;
#pragma unroll
        for (int ai = 0; ai < 2; ++ai)
#pragma unroll
            for (int m = 0; m < 4; ++m) { unsigned char* rowp = H + (size_t)(row0 + ai * HALF + m * 16) * 3584 + col0;
                const float c1 = -1.4426950408889634f * ascale, c2 = ascale * ascale * hscale;
                const f32x4 g0 = acc[ai][0][m][0], g1 = acc[ai][0][m][1], u0 = acc[ai][1][m][0], u1 = acc[ai][1][m][1];
                const f32x2 a = sig_mul2((f32x2){g0[0], g0[1]} * c1, (f32x2){g0[0], g0[1]} * (f32x2){u0[0], u0[1]} * c2), b = sig_mul2((f32x2){g0[2], g0[3]} * c1, (f32x2){g0[2], g0[3]} * (f32x2){u0[2], u0[3]} * c2);
                const f32x2 c = sig_mul2((f32x2){g1[0], g1[1]} * c1, (f32x2){g1[0], g1[1]} * (f32x2){u1[0], u1[1]} * c2), d = sig_mul2((f32x2){g1[2], g1[3]} * c1, (f32x2){g1[2], g1[3]} * (f32x2){u1[2], u1[3]} * c2);
                const f32x4 h0 = (f32x4){a.x, a.y, b.x, b.y}, h1 = (f32x4){c.x, c.y, d.x, d.y};
                u32x2 w; w.x = pk4_fp8(h0[0], h0[1], h0[2], h0[3]); w.y = pk4_fp8(h1[0], h1[1], h1[2], h1[3]); *(u32x2*)rowp = w; }
    }
};
struct EpiSwigluI8 {
    static constexpr bool PERM = true, AFTER_DRAIN = false;
    bf16_t* H; const float* rowscale; const float* cs_gate; const float* cs_up; float hscale;
    __device__ __forceinline__ void operator()(const f32x4 (&acc)[2][2][4][2], const Unit& u, int wr, int wc, int fr, int fq) const {
        typedef int i32x4 __attribute__((ext_vector_type(4)));
        const int row0 = u.om * BM + wr * 64 + fr, col0 = u.on * HALF + wc * 32 + 8 * fq;
        const f32x4 g0 = *(const f32x4*)(cs_gate + col0), g1 = *(const f32x4*)(cs_gate + col0 + 4), gu0 = g0 * *(const f32x4*)(cs_up + col0), gu1 = g1 * *(const f32x4*)(cs_up + col0 + 4);
#pragma unroll
        for (int ai = 0; ai < 2; ++ai)
#pragma unroll
            for (int m = 0; m < 4; ++m) { const int r = row0 + ai * HALF + m * 16; const float rs = rowscale[r]; bf16_t* rowp = H + (size_t)r * 3584 + col0;
                const i32x4 ag0 = __builtin_bit_cast(i32x4, acc[ai][0][m][0]), ag1 = __builtin_bit_cast(i32x4, acc[ai][0][m][1]), au0 = __builtin_bit_cast(i32x4, acc[ai][1][m][0]), au1 = __builtin_bit_cast(i32x4, acc[ai][1][m][1]);
                const float rs1 = -1.4426950408889634f * rs, rs2 = rs * rs;
                f32x4 h0, h1;
#pragma unroll
                for (int j = 0; j < 4; j += 2) {
                    const f32x2 a = sig_mul2((f32x2){(float)ag0[j], (float)ag0[j + 1]} * ((f32x2){g0[j], g0[j + 1]} * rs1), (f32x2){(float)ag0[j], (float)ag0[j + 1]} * (f32x2){(float)au0[j], (float)au0[j + 1]} * ((f32x2){gu0[j], gu0[j + 1]} * rs2));
                    const f32x2 b = sig_mul2((f32x2){(float)ag1[j], (float)ag1[j + 1]} * ((f32x2){g1[j], g1[j + 1]} * rs1), (f32x2){(float)ag1[j], (float)ag1[j + 1]} * (f32x2){(float)au1[j], (float)au1[j + 1]} * ((f32x2){gu1[j], gu1[j + 1]} * rs2));
                    h0[j] = a.x; h0[j + 1] = a.y; h1[j] = b.x; h1[j + 1] = b.y; }
                if (DOWN0_FP8) { typedef unsigned u32x2 __attribute__((ext_vector_type(2))); u32x2 w; w.x = pk4_fp8(h0[0] * hscale, h0[1] * hscale, h0[2] * hscale, h0[3] * hscale); w.y = pk4_fp8(h1[0] * hscale, h1[1] * hscale, h1[2] * hscale, h1[3] * hscale);
                    *(u32x2*)((unsigned char*)H + (size_t)r * 3584 + col0) = w; }
                else *(u32x4*)rowp = pack8(h0, h1); }
    }
};
struct EpiPlainI8 {
    static constexpr bool PERM = true, AFTER_DRAIN = false;
    bf16_t* O; int ldc; const float* rowscale; const float* colscale;
    __device__ __forceinline__ void operator()(const f32x4 (&acc)[2][2][4][2], const Unit& u, int wr, int wc, int fr, int fq) const {
        typedef int i32x4 __attribute__((ext_vector_type(4)));
        const int row0 = u.om * BM + wr * 64 + fr, col0 = u.on * BM + wc * 32 + 8 * fq;
        f32x4 cs[2][2];
#pragma unroll
        for (int bj = 0; bj < 2; ++bj) { cs[bj][0] = *(const f32x4*)(colscale + col0 + bj * HALF); cs[bj][1] = *(const f32x4*)(colscale + col0 + bj * HALF + 4); }
#pragma unroll
        for (int ai = 0; ai < 2; ++ai)
#pragma unroll
            for (int m = 0; m < 4; ++m) { const int r = row0 + ai * HALF + m * 16; const float rs = rowscale[r]; bf16_t* rowp = O + (size_t)r * ldc + col0;
#pragma unroll
                for (int bj = 0; bj < 2; ++bj) { const i32x4 a0 = __builtin_bit_cast(i32x4, acc[ai][bj][m][0]), a1 = __builtin_bit_cast(i32x4, acc[ai][bj][m][1]);
                    const f32x4 v0 = (f32x4){(float)a0[0], (float)a0[1], (float)a0[2], (float)a0[3]} * (cs[bj][0] * rs), v1 = (f32x4){(float)a1[0], (float)a1[1], (float)a1[2], (float)a1[3]} * (cs[bj][1] * rs);
                    *(u32x4*)(rowp + bj * HALF) = pack8(v0, v1); } }
    }
};
struct EpiMoeDown {
    static constexpr bool PERM = true, AFTER_DRAIN = false;
    bf16_t* Y; const float* sw; float ascale;
    __device__ __forceinline__ void operator()(const f32x4 (&acc)[2][2][4][2], const Unit& u, int wr, int wc, int fr, int fq) const {
        const int row0 = u.om * BM + wr * 64 + fr, col0 = u.on * BM + wc * 32 + 8 * fq;
#pragma unroll
        for (int ai = 0; ai < 2; ++ai)
#pragma unroll
            for (int m = 0; m < 4; ++m) { const int r = row0 + ai * HALF + m * 16; const float s = sw[r] * ascale; bf16_t* rowp = Y + (size_t)r * 1024 + col0;
#pragma unroll
                for (int bj = 0; bj < 2; ++bj) *(u32x4*)(rowp + bj * HALF) = pack8(acc[ai][bj][m][0] * s, acc[ai][bj][m][1] * s); }
    }
};

typedef int i32x4 __attribute__((ext_vector_type(4)));
typedef int i32x8 __attribute__((ext_vector_type(8)));
__device__ __forceinline__ i32x8 cat8(bf16x8 a, bf16x8 b) { const i32x4 x = __builtin_bit_cast(i32x4, a), y = __builtin_bit_cast(i32x4, b); return __builtin_shufflevector(x, y, 0, 1, 2, 3, 4, 5, 6, 7); }
template <class Epi, class Sched, bool ALIGN_EPI = false, bool SP2 = false, int MODE = 0>
__device__ __forceinline__ void gemm_phase(PG8_LAS unsigned char* lds, const Gemm g, const Sched& S, const Epi& E, int wid) {
    constexpr bool FP8 = (MODE == 1);
    int lane; asm volatile("v_mbcnt_lo_u32_b32 %0, -1, 0\n\tv_mbcnt_hi_u32_b32 %0, -1, %0" : "=v"(lane));
    const int tid = wid * 64 + lane, wr = wid >> 2, wc = wid & 3, fr = lane & 15, fq = lane >> 4;
    const int K = g.K, nt = K / BK;
    unsigned voffA[2], voffB[2];
#pragma unroll
    for (int i = 0; i < 2; ++i) { int R, C; stage_rc(tid * 16 + i * 8192, R, C); static_assert(Epi::PERM, "weight copies are stored with each 32-row group already in perm32 order"); const int Rb = R;
        voffA[i] = (unsigned)(R * K + C) * 2u; voffB[i] = (unsigned)(Rb * K + C) * 2u; }
    const unsigned kstep = (unsigned)(BK * 2);
    const unsigned hstep = (unsigned)HALF * K * 2;
    const unsigned tstep = 2 * hstep;
    const __amdgpu_buffer_rsrc_t rs_voffA = __builtin_amdgcn_make_buffer_rsrc((void*)g.A, 0, 0x7fffffff, 0x00020000), rs_voffB = __builtin_amdgcn_make_buffer_rsrc((void*)g.Bt, 0, 0x7fffffff, 0x00020000);
    const unsigned ldsw = (unsigned)wid * 1024u;
    const int aoff = lds_byte(wr * 64 + fr, fq * 8), boff = lds_byte(wc * 32 + fr, fq * 8);
#define PG8_SA(b, h) (((b) * 2 + (h)) * HTB)
#define PG8_SB(b, h) ((4 + (b) * 2 + (h)) * HTB)
#define PG8_STAGE(bufoff, gbase, voff) do { _Pragma("unroll") for (int _i = 0; _i < 2; ++_i) \
        __builtin_amdgcn_raw_ptr_buffer_load_lds(rs_##voff, (PG8_LAS void*)(lds + (bufoff) + ldsw + _i * 8192), 16, (int)(voff)[_i], (int)(gbase), 0, 0); } while (0)
#define PG8_LDA(dst, b, h) do { if constexpr (FP8) { _Pragma("unroll") for (int m = 0; m < 4; ++m) { const i32x4 lo_ = *(const PG8_LAS i32x4*)(lds + PG8_SA(b, h) + aoff + m * 2048), hi_ = *(const PG8_LAS i32x4*)(lds + PG8_SA(b, h) + aoff + m * 2048 + 1024); dst##8[m] = __builtin_shufflevector(lo_, hi_, 0, 1, 2, 3, 4, 5, 6, 7); } } \
    else { _Pragma("unroll") for (int m = 0; m < 4; ++m) _Pragma("unroll") for (int k = 0; k < 2; ++k) dst[m][k] = *(const PG8_LAS bf16x8*)(lds + PG8_SA(b, h) + aoff + m * 2048 + k * 1024); } } while (0)
#define PG8_LDB(dst, b, h) do { if constexpr (FP8) { _Pragma("unroll") for (int n = 0; n < 2; ++n) { const i32x4 lo_ = *(const PG8_LAS i32x4*)(lds + PG8_SB(b, h) + boff + n * 2048), hi_ = *(const PG8_LAS i32x4*)(lds + PG8_SB(b, h) + boff + n * 2048 + 1024); dst##8[n] = __builtin_shufflevector(lo_, hi_, 0, 1, 2, 3, 4, 5, 6, 7); } } \
    else { _Pragma("unroll") for (int n = 0; n < 2; ++n) _Pragma("unroll") for (int k = 0; k < 2; ++k) dst[n][k] = *(const PG8_LAS bf16x8*)(lds + PG8_SB(b, h) + boff + n * 2048 + k * 1024); } } while (0)
#define PG8_MMA(ai, bj, At, Bt) do { __builtin_amdgcn_s_setprio(1); \
        if constexpr (FP8) { _Pragma("unroll") for (int m = 0; m < 4; ++m) _Pragma("unroll") for (int n = 0; n < 2; ++n) \
            acc[ai][bj][m][n] = __builtin_amdgcn_mfma_scale_f32_16x16x128_f8f6f4(Bt##8[n], At##8[m], acc[ai][bj][m][n], 0, 0, 0, 0x7f7f7f7f, 0, 0x7f7f7f7f); } \
        else if constexpr (MODE == 2) { _Pragma("unroll") for (int m = 0; m < 4; ++m) _Pragma("unroll") for (int n = 0; n < 2; ++n) _Pragma("unroll") for (int k = 0; k < 2; ++k) \
            acc[ai][bj][m][n] = __builtin_bit_cast(f32x4, __builtin_amdgcn_mfma_i32_16x16x64_i8(__builtin_bit_cast(i32x4, Bt[n][k]), __builtin_bit_cast(i32x4, At[m][k]), __builtin_bit_cast(i32x4, acc[ai][bj][m][n]), 0, 0, 0)); } \
        else { _Pragma("unroll") for (int m = 0; m < 4; ++m) _Pragma("unroll") for (int n = 0; n < 2; ++n) _Pragma("unroll") for (int k = 0; k < 2; ++k) \
            acc[ai][bj][m][n] = __builtin_amdgcn_mfma_f32_16x16x32_bf16(Bt[n][k], At[m][k], acc[ai][bj][m][n], 0, 0, 0); } \
        __builtin_amdgcn_s_setprio(0); } while (0)
#define PG8_WAIT_V(n) asm volatile("s_waitcnt vmcnt(" #n ")" ::: "memory")
#define PG8_WAIT_L(n) asm volatile("s_waitcnt lgkmcnt(" #n ")" ::: "memory")
#define PG8_BAR __builtin_amdgcn_s_barrier()
#define PG8_SCHED __builtin_amdgcn_sched_barrier(0)
    Unit cur, nxt; int ui = 0;
    if (!S.next(0, cur)) return;
    f32x4 acc[2][2][4][2];
#pragma unroll
    for (int a = 0; a < 2; ++a)
#pragma unroll
        for (int b = 0; b < 2; ++b)
#pragma unroll
            for (int m = 0; m < 4; ++m)
#pragma unroll
                for (int n = 0; n < 2; ++n) acc[a][b][m][n] = (f32x4){0.f, 0.f, 0.f, 0.f};
    bf16x8 At[4][2], B0[2][2], B1[2][2]; i32x8 At8[4], B08[2], B18[2];
    unsigned cA = (unsigned)cur.pm * tstep, cB = (unsigned)cur.pn * tstep;
    S.a_ready(cur);
    if constexpr (SP2) {
        PG8_STAGE(PG8_SB(0, 0), cB, voffB); PG8_STAGE(PG8_SB(0, 1), cB + hstep, voffB); PG8_STAGE(PG8_SA(0, 0), cA, voffA); PG8_STAGE(PG8_SA(0, 1), cA + hstep, voffA);
        if (wr == 1) PG8_BAR;
        PG8_WAIT_V(2); PG8_BAR;
        PG8_STAGE(PG8_SB(1, 0), cB + kstep, voffB); PG8_STAGE(PG8_SA(1, 0), cA + kstep, voffA); PG8_STAGE(PG8_SB(1, 1), cB + hstep + kstep, voffB);
        PG8_WAIT_V(6); PG8_BAR;
    } else {
        PG8_STAGE(PG8_SB(0, 0), cB, voffB); PG8_STAGE(PG8_SA(0, 0), cA, voffA); PG8_STAGE(PG8_SB(0, 1), cB + hstep, voffB); PG8_STAGE(PG8_SA(0, 1), cA + hstep, voffA);
        if (wr == 1) PG8_BAR;
        PG8_WAIT_V(4); PG8_BAR;
        PG8_STAGE(PG8_SB(1, 0), cB + kstep, voffB); PG8_STAGE(PG8_SA(1, 0), cA + kstep, voffA); PG8_STAGE(PG8_SB(1, 1), cB + hstep + kstep, voffB);
        PG8_WAIT_V(6); PG8_BAR;
    }
    for (;;) {
        const bool has_next = S.next(ui + 1, nxt);
        const unsigned nA = has_next ? (unsigned)nxt.pm * tstep : cA, nB = has_next ? (unsigned)nxt.pn * tstep : cB;
        asm volatile(".p2align 8");
#pragma unroll 1
        for (int t = 0; t < nt; t += 2) {
            const bool last = (t == nt - 2);
            const unsigned a1 = cA + (unsigned)(t + 1) * kstep;
            const unsigned a2 = last ? nA : cA + (unsigned)(t + 2) * kstep, b2 = last ? nB : cB + (unsigned)(t + 2) * kstep;
            const unsigned a3 = a2 + kstep, b3 = b2 + kstep;
            if (last && has_next) S.a_ready(nxt);
            if constexpr (SP2) {
            PG8_LDB(B0, 0, 0); PG8_LDB(B1, 0, 1); PG8_SCHED; PG8_LDA(At, 0, 0); PG8_STAGE(PG8_SA(1, 1), a1 + hstep, voffA);
            PG8_WAIT_V(8); PG8_WAIT_L(0); PG8_BAR; PG8_MMA(0, 0, At, B0); PG8_MMA(0, 1, At, B1); PG8_BAR; PG8_SCHED;
            PG8_LDA(At, 0, 1); PG8_STAGE(PG8_SB(0, 0), b2, voffB); PG8_STAGE(PG8_SB(0, 1), b2 + hstep, voffB); PG8_STAGE(PG8_SA(0, 0), a2, voffA);
            PG8_WAIT_V(8); PG8_WAIT_L(0); PG8_BAR; PG8_MMA(1, 0, At, B0); PG8_MMA(1, 1, At, B1); PG8_BAR; PG8_SCHED;
            PG8_LDB(B0, 1, 0); PG8_LDB(B1, 1, 1); PG8_SCHED; PG8_LDA(At, 1, 0); PG8_STAGE(PG8_SA(0, 1), a2 + hstep, voffA);
            PG8_WAIT_V(8); PG8_WAIT_L(0); PG8_BAR; PG8_MMA(0, 0, At, B0); PG8_MMA(0, 1, At, B1); PG8_BAR; PG8_SCHED;
            PG8_LDA(At, 1, 1); PG8_STAGE(PG8_SB(1, 0), b3, voffB); PG8_STAGE(PG8_SB(1, 1), b3 + hstep, voffB); PG8_STAGE(PG8_SA(1, 0), a3, voffA);
            PG8_WAIT_V(8); PG8_WAIT_L(0); PG8_BAR; PG8_MMA(1, 0, At, B0); PG8_MMA(1, 1, At, B1); PG8_BAR; PG8_SCHED;
            } else {
            PG8_LDB(B0, 0, 0); PG8_SCHED; PG8_LDA(At, 0, 0); PG8_STAGE(PG8_SA(1, 1), a1 + hstep, voffA);
            PG8_WAIT_L(8); PG8_BAR; PG8_WAIT_L(0); PG8_MMA(0, 0, At, B0); PG8_BAR; PG8_SCHED;
            PG8_LDB(B1, 0, 1); PG8_STAGE(PG8_SB(0, 0), b2, voffB);
            PG8_BAR; PG8_WAIT_L(0); PG8_MMA(0, 1, At, B1); PG8_BAR;
            PG8_LDA(At, 0, 1); PG8_STAGE(PG8_SA(0, 0), a2, voffA);
            PG8_BAR; PG8_WAIT_L(0); PG8_MMA(1, 0, At, B0); PG8_BAR; PG8_SCHED;
            PG8_STAGE(PG8_SB(0, 1), b2 + hstep, voffB);
            PG8_WAIT_V(6); PG8_BAR; PG8_MMA(1, 1, At, B1); PG8_BAR;
            PG8_LDB(B0, 1, 0); PG8_SCHED; PG8_LDA(At, 1, 0); PG8_STAGE(PG8_SA(0, 1), a2 + hstep, voffA);
            PG8_WAIT_L(8); PG8_BAR; PG8_WAIT_L(0); PG8_MMA(0, 0, At, B0); PG8_BAR; PG8_SCHED;
            PG8_LDB(B1, 1, 1); PG8_STAGE(PG8_SB(1, 0), b3, voffB);
            PG8_BAR; PG8_WAIT_L(0); PG8_MMA(0, 1, At, B1); PG8_BAR;
            PG8_LDA(At, 1, 1); PG8_STAGE(PG8_SA(1, 0), a3, voffA);
            PG8_BAR; PG8_WAIT_L(0); PG8_MMA(1, 0, At, B0); PG8_BAR; PG8_SCHED;
            PG8_STAGE(PG8_SB(1, 1), b3 + hstep, voffB);
            PG8_WAIT_V(6); PG8_BAR; PG8_MMA(1, 1, At, B1); PG8_BAR;
            }
        }
        if constexpr (ALIGN_EPI) { if (wr == 0) PG8_BAR; }
        if constexpr (!Epi::AFTER_DRAIN) { E(acc, cur, wr, wc, fr, fq); S.done(cur); }
        if (!has_next) break;
#pragma unroll
        for (int a = 0; a < 2; ++a)
#pragma unroll
            for (int b = 0; b < 2; ++b)
#pragma unroll
                for (int m = 0; m < 4; ++m)
#pragma unroll
                    for (int n = 0; n < 2; ++n) acc[a][b][m][n] = (f32x4){0.f, 0.f, 0.f, 0.f};
        cur = nxt; cA = nA; cB = nB; ++ui;
        if constexpr (ALIGN_EPI) { if (wr == 1) PG8_BAR; }
    }
    PG8_WAIT_V(0);
    if constexpr (!ALIGN_EPI) { if (wr == 0) PG8_BAR; }
    PG8_BAR;
    if constexpr (Epi::AFTER_DRAIN) { E.fused(acc, cur, wr, wc, fr, fq, lds, wid, lane); S.done(cur); }
#undef PG8_SA
#undef PG8_SB
#undef PG8_STAGE
#undef PG8_LDA
#undef PG8_LDB
#undef PG8_MMA
#undef PG8_WAIT_V
#undef PG8_WAIT_L
#undef PG8_BAR
#undef PG8_SCHED
}
}

constexpr int NWAVES = 8;
constexpr int BATCH = 16, SEQ = 2048, D = 1024, M = BATCH * SEQ, MEML = 256, MEMR = BATCH * MEML;
constexpr int NHS = 12, NKV0 = 3, NCH = 4, HD = 64, FF = 3584, NEXP = 8;
constexpr int N0 = 1536, N1 = 2560;
constexpr int P0_Q = 0, P0_K = 768, P0_V = 1024, P0_QC = 1216;
constexpr int P1_Q = 0, P1_K = 768, P1_V = 1536, P1_QC = 2304;
constexpr float RMS_EPS = 1e-6f, LOG2E = 1.4426950408889634f, QSCALE = 0.125f * LOG2E;
constexpr int SLOTS = 2 * M + NEXP * 256, TMAX = SLOTS / 256;
constexpr int CHT = 128, NCHUNK = 3;
#if MOE_FP8
constexpr int PH_FINAL = 16;
constexpr int TAIL_TILE0 = 256, TAIL_SLOT0 = TAIL_TILE0 * 256;
#else
constexpr int PH_FINAL = 19;
#endif
constexpr float XS_SCALE = 8.f, WGU_SCALE = 256.f, H_SCALE = 16.f, WDN_SCALE = 512.f;
constexpr int NPHASE = PH_FINAL + 1;

constexpr size_t MiB = 1u << 20;
constexpr size_t WS_CTL = 0, CTL_ZERO_BYTES = 1 * MiB;
constexpr size_t WS_TAB = 1 * MiB;
constexpr size_t TAB_ROWSC = 0, TAB_CSG = 128 * 1024, TAB_CSU = 160 * 1024, TAB_CS1 = 192 * 1024, TAB_CS0 = 208 * 1024, TAB_ROWSC0 = 384 * 1024;
constexpr size_t TAB_TOKE = 0, TAB_TOKW = 128 * 1024, TAB_TOKSLOT = 384 * 1024, TAB_WOFF = 640 * 1024, TAB_WGH = 704 * 1024, TAB_EST = 712 * 1024, TAB_SLOTW = 720 * 1024;
constexpr size_t WS_MIX = 2 * MiB;
#if MOE_FP8
constexpr size_t WS_W1GU = 2 * MiB, WS_W1DOWN = 58 * MiB;
constexpr size_t WS_RES = 86 * MiB;
constexpr size_t WS_XS = 184 * MiB;
constexpr size_t WS_XN8U = 152 * MiB;
constexpr size_t WS_YS = 152 * MiB;
constexpr size_t WS_HID8 = 284 * MiB;
#else
constexpr size_t WS_W1GU = 2 * MiB, WS_W1DOWN = 114 * MiB;
constexpr size_t WS_XS = 170 * MiB, WS_YS = 170 * MiB;
#endif
constexpr size_t WS_XN = 170 * MiB;
constexpr size_t WS_ROPE = 250 * MiB, WS_MEMKV = 258 * MiB;
constexpr size_t WS_W0IN = 266 * MiB, WS_W0OUT = 271 * MiB, WS_W0GU = 273 * MiB, WS_W0DOWN = 287 * MiB, WS_W1IN = 294 * MiB, WS_W1OUT = 299 * MiB;
constexpr size_t WS_HID = 302 * MiB;
constexpr size_t WS_PROJ = 302 * MiB, WS_ATT = 462 * MiB, WS_END = 526 * MiB;
#if MOE_FP8
static_assert(WS_W1GU + (size_t)NEXP * 2 * FF * D <= WS_W1DOWN && WS_W1DOWN + (size_t)NEXP * D * FF <= WS_RES && WS_RES + (size_t)M * D * 2 <= WS_XN8U && WS_XN8U + (size_t)M * D <= WS_XS && WS_XS + (size_t)SLOTS * D <= WS_HID8 && WS_MIX + (size_t)M * D * 2 <= WS_RES && WS_RES + (size_t)M * D * 2 <= WS_XN && WS_YS + (size_t)SLOTS * D * 2 <= WS_HID8 && WS_HID8 + (size_t)SLOTS * FF <= WS_END, "d_ws map (fp8 experts)");
#else
static_assert(WS_XS + (size_t)SLOTS * D * 2 <= WS_HID && WS_W1DOWN + (size_t)NEXP * D * FF * 2 <= WS_XS, "d_ws map (bf16 experts)");
#endif
static_assert(WS_W1OUT + 2 * MiB <= WS_HID && WS_HID + (size_t)M * FF * 2 <= WS_END, "d_ws map");
constexpr int CW_TMO = 0, CW_BAR = 4096, CW_CMAX = 131072, CW_CMAX1 = CW_CMAX + 2 * FF;

constexpr int RING_OFF = 0, RING_BYTES = 131072;
constexpr int LDSCTL_OFF = RING_BYTES, MISC_OFF = LDSCTL_OFF + 320;
constexpr int ETAB_OFF = MISC_OFF + 128;
constexpr int LDS_BYTES = 147456;
static_assert(ETAB_OFF + 512 <= LDS_BYTES, "LDS map");

#define GAS __attribute__((address_space(1)))
#define LAS __attribute__((address_space(3)))
typedef unsigned short bf16;
typedef unsigned v4u __attribute__((ext_vector_type(4)));
typedef unsigned v2u __attribute__((ext_vector_type(2)));
typedef float f32x4 __attribute__((ext_vector_type(4)));
typedef GAS unsigned gu32;
#define RLX_AGENT __ATOMIC_RELAXED, __HIP_MEMORY_SCOPE_AGENT
#define LDS_WAIT() asm volatile("s_waitcnt lgkmcnt(0)" ::: "memory")
#define VM_WAIT() asm volatile("s_waitcnt vmcnt(0)" ::: "memory")
__device__ __forceinline__ unsigned f2bf(float f) { unsigned u = __builtin_bit_cast(unsigned, f); return (u + 0x7fffu + ((u >> 16) & 1u)) >> 16; }
__device__ __forceinline__ unsigned pk2(float lo, float hi) { return f2bf(lo) | (f2bf(hi) << 16); }
__device__ __forceinline__ float bflo(unsigned w) { return __uint_as_float(w << 16); }
__device__ __forceinline__ float bfhi(unsigned w) { return __uint_as_float(w & 0xffff0000u); }
template <class T> __device__ __forceinline__ const GAS T* vptr(const T* p) { unsigned long long a = (unsigned long long)p; unsigned lo = (unsigned)a, hi = (unsigned)(a >> 32); asm volatile("" : "+v"(lo), "+v"(hi)); return (const GAS T*)(((unsigned long long)hi << 32) | lo); }

#define XB_TMO      128
#define XB_XCNT(j)  (256  + 64 * (j))
#define XB_XSUB(j)  (1280 + 64 * (j))
#define XB_XGEN(j)  (2304 + 64 * (j))
#define XB_TOP      3328
#define XB_TOPGEN   3392
#define XCD_BAR_WORDS 3456
#define XB_SPIN_CAP (1u << 22)

__device__ __forceinline__ unsigned xb_ld(unsigned* p)              { return __hip_atomic_load(p, __ATOMIC_RELAXED, __HIP_MEMORY_SCOPE_AGENT); }
__device__ __forceinline__ unsigned xb_add(unsigned* p, unsigned v) { return __hip_atomic_fetch_add(p, v, __ATOMIC_RELAXED, __HIP_MEMORY_SCOPE_AGENT); }
__device__ __forceinline__ unsigned xb_xcc_id() { return (unsigned)__builtin_amdgcn_s_getreg((3 << 11) | 20) & 0xFu; }
#define XB_SPIN(cond, bar) do { unsigned _sp = 0; while (cond) { __builtin_amdgcn_s_sleep(1); \
    if ((++_sp & 255u) == 0u) { if (xb_ld(&(bar)[XB_TMO])) break; if (_sp > XB_SPIN_CAP) { atomicAdd(&(bar)[XB_TMO], 1u); break; } } } } while (0)

struct XcdBarrier {
    unsigned* bar; unsigned x;
    volatile LAS unsigned* st;
};

__device__ __forceinline__ XcdBarrier xcd_barrier_post(unsigned* bar, volatile LAS unsigned* st) {
    XcdBarrier b; b.bar = bar; b.x = xb_xcc_id(); b.st = st;
    if (threadIdx.x == 0) (void)xb_add(&bar[XB_XCNT(b.x)], 1u);
    return b;
}
__device__ __forceinline__ void xcd_barrier_complete(unsigned* bar, unsigned x, unsigned& nloc, unsigned& nx) {
    const unsigned G = gridDim.x * gridDim.y * gridDim.z;
    unsigned sum, cnt, mine, sp = 0u;
    for (;;) {
        sum = 0u; cnt = 0u; mine = 0u;
#pragma unroll
        for (unsigned j = 0; j < 16; ++j) { const unsigned c = xb_ld(&bar[XB_XCNT(j)]); sum += c; cnt += (c > 0u) ? 1u : 0u; mine = (j == x) ? c : mine; }
        if (sum == G) break;
        __builtin_amdgcn_s_sleep(1);
        if ((++sp & 255u) == 0u) { if (xb_ld(&bar[XB_TMO])) break; if (sp > XB_SPIN_CAP) { atomicAdd(&bar[XB_TMO], 1u); break; } }
    }
    nloc = mine > 0u ? mine : 1u; nx = cnt > 0u ? cnt : 1u;
}

__device__ __forceinline__ void xcd_barrier(const XcdBarrier& b) {
    asm volatile("s_waitcnt vmcnt(0)" ::: "memory");
    __syncthreads();
    if (threadIdx.x == 0) {
        unsigned* bar = b.bar;
        __builtin_amdgcn_s_waitcnt(0);
        unsigned nloc = b.st[0], nx = b.st[1];
        if (nloc == 0u) { xcd_barrier_complete(bar, b.x, nloc, nx); b.st[0] = nloc; b.st[1] = nx; }
        const unsigned old = xb_add(&bar[XB_XSUB(b.x)], 1u);
        const unsigned gen = old / nloc;
        if (old + 1u == (gen + 1u) * nloc) {
            __builtin_amdgcn_fence(__ATOMIC_RELEASE, "agent");
            asm volatile("s_waitcnt vmcnt(0)" ::: "memory");
            const unsigned og = xb_add(&bar[XB_TOP], 1u);
            const unsigned tg = og / nx;
            if (og + 1u == (tg + 1u) * nx) xb_add(&bar[XB_TOPGEN], 1u);
            else XB_SPIN(xb_ld(&bar[XB_TOPGEN]) == tg, bar);
            __builtin_amdgcn_fence(__ATOMIC_ACQUIRE, "agent");
            xb_add(&bar[XB_XGEN(b.x)], 1u);
            asm volatile("s_waitcnt vmcnt(0)" ::: "memory");
        } else {
            XB_SPIN(xb_ld(&bar[XB_XGEN(b.x)]) == gen, bar);
            __builtin_amdgcn_fence(__ATOMIC_ACQUIRE, "agent");
            asm volatile("s_waitcnt vmcnt(0)" ::: "memory");
        }
    }
    __syncthreads();
}

struct Args { const void* in[27]; float* out; unsigned char* ws; int ph_lo, ph_hi, li, pad; };
struct Frame {
    LAS unsigned char* lds; volatile LAS unsigned* MISC; gu32* ctl;
    int tid, lane, wave, G, c;
    unsigned char* ws; float* out;
};
__device__ __forceinline__ void refresh_ids(Frame& F) { int l; asm volatile("v_mbcnt_lo_u32_b32 %0, -1, 0\n\tv_mbcnt_hi_u32_b32 %0, -1, %0" : "=v"(l)); F.lane = l; F.tid = F.wave * 64 + l; }
__device__ __forceinline__ float wave_sum(float v) {
#pragma unroll
    for (int o = 1; o < 64; o <<= 1) v += __shfl_xor(v, o);
    return v;
}
__device__ __forceinline__ int wave_sum_i(int v) {
#pragma unroll
    for (int o = 1; o < 64; o <<= 1) v += __shfl_xor(v, o);
    return v;
}
__device__ __forceinline__ void ld_row_f32(const float* row, int lane, f32x4 (&v)[4]) {
#pragma unroll
    for (int j = 0; j < 4; ++j) v[j] = *(const f32x4*)(row + 4 * lane + 256 * j);
}
__device__ __forceinline__ void st_row_f32(float* row, int lane, const f32x4 (&v)[4]) {
#pragma unroll
    for (int j = 0; j < 4; ++j) *(f32x4*)(row + 4 * lane + 256 * j) = v[j];
}
__device__ __forceinline__ void ld_row_bf16(const bf16* row, int lane, f32x4 (&v)[4]) {
#pragma unroll
    for (int j = 0; j < 4; ++j) { const v2u w = *(const v2u*)(row + 4 * lane + 256 * j); v[j] = (f32x4){bflo(w.x), bfhi(w.x), bflo(w.y), bfhi(w.y)}; }
}
__device__ __forceinline__ void st_row_bf16(bf16* row, int lane, const f32x4 (&v)[4]) {
#pragma unroll
    for (int j = 0; j < 4; ++j) { v2u w; w.x = pk2(v[j][0], v[j][1]); w.y = pk2(v[j][2], v[j][3]); *(v2u*)(row + 4 * lane + 256 * j) = w; }
}
__device__ __forceinline__ void ld_row_f32_nt(const float* row, int lane, f32x4 (&v)[4]) {
#pragma unroll
    for (int j = 0; j < 4; ++j) v[j] = __builtin_nontemporal_load((const f32x4*)(row + 4 * lane + 256 * j));
}
__device__ __forceinline__ void st_row_f32_nt(float* row, int lane, const f32x4 (&v)[4]) {
#pragma unroll
    for (int j = 0; j < 4; ++j) __builtin_nontemporal_store(v[j], (f32x4*)(row + 4 * lane + 256 * j));
}
__device__ __forceinline__ void ld_row_bf16_nt(const bf16* row, int lane, f32x4 (&v)[4]) {
#pragma unroll
    for (int j = 0; j < 4; ++j) { const v2u w = __builtin_nontemporal_load((const v2u*)(row + 4 * lane + 256 * j)); v[j] = (f32x4){bflo(w.x), bfhi(w.x), bflo(w.y), bfhi(w.y)}; }
}
__device__ __forceinline__ void st_row_bf16_nt(bf16* row, int lane, const f32x4 (&v)[4]) {
#pragma unroll
    for (int j = 0; j < 4; ++j) { v2u w; w.x = pk2(v[j][0], v[j][1]); w.y = pk2(v[j][2], v[j][3]); __builtin_nontemporal_store(w, (v2u*)(row + 4 * lane + 256 * j)); }
}
__device__ __forceinline__ float row_rstd(const f32x4 (&v)[4]) {
    float s = 0.f;
#pragma unroll
    for (int j = 0; j < 4; ++j) s += (v[j][0] * v[j][0] + v[j][1] * v[j][1]) + (v[j][2] * v[j][2] + v[j][3] * v[j][3]);
    return 1.0f / sqrtf(wave_sum(s) * (1.0f / D) + RMS_EPS);
}

struct ColSrc { const float* W; int N; int col; float scale; };
struct MapIn0 { const float* W;
    __device__ __forceinline__ ColSrc operator()(int n) const { ColSrc s; s.W = W; s.N = 1408; s.scale = 1.f; s.col = 0;
        if (n < 960) { const int h = n >> 6, p = n & 63; s.col = h * 64 + ((p >> 2) & 1) * 32 + (p >> 5) * 16 + ((p >> 3) & 3) * 4 + (p & 3); if (n < 768) s.scale = QSCALE; }
        else if (n < 1024) s.W = nullptr;
        else if (n < 1216) s.col = 960 + (n - 1024);
        else if (n < 1472) { s.col = 1152 + (n - 1216); s.scale = QSCALE; }
        else s.W = nullptr;
        return s; } };
struct MapIdent { const float* W; int N; int lo_end, hi_begin; float s_edge, s_mid;
    __device__ __forceinline__ ColSrc operator()(int n) const { ColSrc s; s.W = W; s.N = N; s.col = n; s.scale = (n < lo_end || n >= hi_begin) ? s_edge : s_mid; return s; } };
struct MapGU { const float* g; const float* u; float sc;
    __device__ __forceinline__ ColSrc operator()(int n) const { ColSrc s; const int j = n >> 8, r = n & 255; const long long du = (long long)((const char*)u - (const char*)g);
        s.W = (const float*)((const char*)g + (r < 128 ? 0ll : du)); s.N = FF; s.col = 128 * j + (r & 127); s.scale = sc; return s; } };
__device__ __forceinline__ unsigned pk4_i8(float a, float b, float c, float d) {
    const int qa = (int)__builtin_rintf(__builtin_amdgcn_fmed3f(a, -127.f, 127.f)), qb = (int)__builtin_rintf(__builtin_amdgcn_fmed3f(b, -127.f, 127.f)), qc = (int)__builtin_rintf(__builtin_amdgcn_fmed3f(c, -127.f, 127.f)), qd = (int)__builtin_rintf(__builtin_amdgcn_fmed3f(d, -127.f, 127.f));
    return ((unsigned)qa & 0xffu) | (((unsigned)qb & 0xffu) << 8) | (((unsigned)qc & 0xffu) << 16) | ((unsigned)qd << 24); }
struct MapGUq { const float* g; const float* u; const unsigned* cmax;
    __device__ __forceinline__ ColSrc operator()(int n) const { ColSrc s; const int j = n >> 8, r = n & 255, isu = r >> 7; const long long du = (long long)((const char*)u - (const char*)g);
        s.W = (const float*)((const char*)g + (isu ? du : 0ll)); s.N = FF; s.col = 128 * j + (r & 127);
        const float am = __uint_as_float(__hip_atomic_load(cmax + isu * FF + s.col, __ATOMIC_RELAXED, __HIP_MEMORY_SCOPE_AGENT)); s.scale = am > 0.f ? 127.0f / am : 0.f; return s; } };
struct MapIdentQ { const float* W; int N; const unsigned* cmax;
    __device__ __forceinline__ ColSrc operator()(int n) const { ColSrc s; s.W = W; s.N = N; s.col = n; const float am = __uint_as_float(__hip_atomic_load(cmax + n, __ATOMIC_RELAXED, __HIP_MEMORY_SCOPE_AGENT)); s.scale = am > 0.f ? 127.0f / am : 0.f; return s; } };
template <class Map> struct MapScaled { Map inner; float sc;
    __device__ __forceinline__ ColSrc operator()(int n) const { ColSrc s = inner(n); s.scale = sc; return s; } };
template <int OM  , class Map> __device__ __forceinline__ void transpose_item(const Map& map, int K, void* WT, int nblk, LAS float* scr, int item, int lane) {
    constexpr bool FP8 = (OM != 0); constexpr int KT = FP8 ? 128 : 64, KC = FP8 ? 16 : 8, SH = FP8 ? 4 : 3;
    const int kb = item / nblk, nb = item % nblk, k0 = KT * kb, n0 = 32 * nb;
    const ColSrc cs = map(n0 + pg8::perm32(lane & 31));
    float v[KT / 2];
    if (cs.W) { const float* src = cs.W + (size_t)(k0 + (lane >> 5)) * cs.N + cs.col;
#pragma unroll
        for (int i = 0; i < KT / 2; ++i) v[i] = __builtin_nontemporal_load(src + (size_t)(2 * i) * cs.N); }
    else {
#pragma unroll
        for (int i = 0; i < KT / 2; ++i) v[i] = 0.f; }
#pragma unroll
    for (int i = 0; i < KT / 2; ++i) { const int kk = 2 * i + (lane >> 5); scr[kk * 32 + (((lane & 31) + 4 * (kk >> SH)) & 31)] = v[i] * cs.scale; }
    LDS_WAIT(); asm volatile("" ::: "memory");
    const int c = lane & 7;
#pragma unroll
    for (int j = 0; j < 4; ++j) { const int n = (lane >> 3) + 8 * j; const LAS float* s = scr + (KC * c) * 32 + ((n + 4 * c) & 31);
        v4u o;
        if (OM == 2) { o.x = pk4_i8(s[0 * 32], s[1 * 32], s[2 * 32], s[3 * 32]); o.y = pk4_i8(s[4 * 32], s[5 * 32], s[6 * 32], s[7 * 32]); o.z = pk4_i8(s[8 * 32], s[9 * 32], s[10 * 32], s[11 * 32]); o.w = pk4_i8(s[12 * 32], s[13 * 32], s[14 * 32], s[15 * 32]);
            *(GAS v4u*)((unsigned char*)WT + (size_t)(n0 + n) * K + k0 + 16 * c) = o; }
        else if (FP8) { o.x = pg8::pk4_fp8(s[0 * 32], s[1 * 32], s[2 * 32], s[3 * 32]); o.y = pg8::pk4_fp8(s[4 * 32], s[5 * 32], s[6 * 32], s[7 * 32]); o.z = pg8::pk4_fp8(s[8 * 32], s[9 * 32], s[10 * 32], s[11 * 32]); o.w = pg8::pk4_fp8(s[12 * 32], s[13 * 32], s[14 * 32], s[15 * 32]);
            *(GAS v4u*)((unsigned char*)WT + (size_t)(n0 + n) * K + k0 + 16 * c) = o; }
        else { o.x = pk2(s[0 * 32], s[1 * 32]); o.y = pk2(s[2 * 32], s[3 * 32]); o.z = pk2(s[4 * 32], s[5 * 32]); o.w = pk2(s[6 * 32], s[7 * 32]);
            *(GAS v4u*)((bf16*)WT + (size_t)(n0 + n) * K + k0 + 8 * c) = o; } }
    LDS_WAIT(); asm volatile("" ::: "memory");
}

__device__ __forceinline__ void p0_prologue(const Args& a, Frame& F, int part, int gw, int NGW) {
    LAS float* scr = (LAS float*)(F.lds + RING_OFF + F.wave * 16384);
    constexpr int I_IN0 = 16 * 48, I_KV = 16 * 16, I_OUT = 16 * 32, I_GU = 16 * 224, I_DN = 56 * 32, I_IN1 = 16 * 80;
    constexpr int NITEMS = I_IN0 + 2 * I_KV + 2 * I_OUT + I_GU + I_DN + I_IN1;
    bf16* w0in = (bf16*)(F.ws + WS_W0IN);
    for (int it = gw; it < NITEMS; it += NGW) {
        int r = it;
        { const bool kvitem = it >= I_IN0 && it < I_IN0 + 2 * I_KV; if ((part == 1 && !kvitem) || (part == 2 && kvitem)) continue; }
#if PROJ0_I8
        if (r < I_IN0 + 2 * I_KV) {
            if (r >= 80) continue;
            const int nb = r, n = 32 * nb + pg8::perm32(F.lane & 31);
            ColSrc cs; float extra = 1.f;
            if (nb < 48) { cs = MapIn0{(const float*)a.in[5]}(n); extra = cs.scale; }
            else if (nb < 64) cs = MapIdent{(const float*)a.in[6], 512, 0, 1 << 30, 1.f, 1.f}(n - 1536);
            else cs = MapIdent{(const float*)a.in[18], 512, 0, 1 << 30, 1.f, 1.f}(n - 2048);
            float am = 0.f;
            if (cs.W) { const float* src = cs.W + (size_t)(F.lane >> 5) * cs.N + cs.col;
                for (int k = 0; k < 512; k += 32) {
#pragma unroll
                    for (int i = 0; i < 32; ++i) am = fmaxf(am, fabsf(src[(size_t)(2 * (k + i)) * cs.N])); } }
            am = fmaxf(am, __shfl_xor(am, 32));
            const float sc = am > 0.f ? 127.0f / am : 0.f;
            if (F.lane < 32) ((float*)(F.ws + WS_TAB + TAB_CS0))[32 * nb + pg8::perm32(F.lane)] = am * (1.0f / 127.0f) * extra;
            for (int kb = 0; kb < 8; ++kb) {
                if (nb < 48) transpose_item<2>(MapScaled<MapIn0>{MapIn0{(const float*)a.in[5]}, sc}, D, (unsigned char*)w0in, 80, scr, kb * 80 + nb, F.lane);
                else if (nb < 64) transpose_item<2>(MapScaled<MapIdent>{MapIdent{(const float*)a.in[6], 512, 0, 1 << 30, 1.f, 1.f}, sc}, D, (unsigned char*)w0in + (size_t)1536 * D, 16, scr, kb * 16 + (nb - 48), F.lane);
                else transpose_item<2>(MapScaled<MapIdent>{MapIdent{(const float*)a.in[18], 512, 0, 1 << 30, 1.f, 1.f}, sc}, D, (unsigned char*)w0in + (size_t)2048 * D, 16, scr, kb * 16 + (nb - 64), F.lane); }
            continue; } r -= I_IN0 + 2 * I_KV;
#else
        if (r < I_IN0) { transpose_item<0>(MapIn0{(const float*)a.in[5]}, D, w0in, 48, scr, r, F.lane); continue; } r -= I_IN0;
        if (r < I_KV) { transpose_item<0>(MapIdent{(const float*)a.in[6], 512, 0, 1 << 30, 1.f, 1.f}, D, w0in + (size_t)1536 * D, 16, scr, r, F.lane); continue; } r -= I_KV;
        if (r < I_KV) { transpose_item<0>(MapIdent{(const float*)a.in[18], 512, 0, 1 << 30, 1.f, 1.f}, D, w0in + (size_t)2048 * D, 16, scr, r, F.lane); continue; } r -= I_KV;
#endif
        if (r < I_OUT) { transpose_item<0>(MapIdent{(const float*)a.in[8], D, 0, 1 << 30, 1.f, 1.f}, D, (bf16*)(F.ws + WS_W0OUT), 32, scr, r, F.lane); continue; } r -= I_OUT;
        if (r < I_OUT) { transpose_item<0>(MapIdent{(const float*)a.in[19], D, 0, 1 << 30, 1.f, 1.f}, D, (bf16*)(F.ws + WS_W1OUT), 32, scr, r, F.lane); continue; } r -= I_OUT;
#if FFN0_MODE == 2
        if (r < I_GU) {
            const int isu = r >= I_GU / 2, rr = r - isu * (I_GU / 2), kb = rr / 112, nb = rr % 112; const float* W = (const float*)a.in[11 + isu] + (size_t)(64 * kb + (F.lane >> 5)) * FF + 32 * nb + (F.lane & 31);
            float am = 0.f;
#pragma unroll
            for (int i = 0; i < 32; ++i) am = fmaxf(am, fabsf(W[(size_t)(2 * i) * FF]));
            am = fmaxf(am, __shfl_xor(am, 32));
            if (F.lane < 32) atomicMax((unsigned*)(F.ctl + CW_CMAX) + isu * FF + 32 * nb + F.lane, __float_as_uint(am));
            continue; } r -= I_GU;
#else
        if (r < I_GU) { transpose_item<0>(MapGU{(const float*)a.in[11], (const float*)a.in[12], 1.f}, D, (bf16*)(F.ws + WS_W0GU), 224, scr, r, F.lane); continue; } r -= I_GU;
#endif
#if DOWN0_FP8 && FFN0_MODE == 2
        if (r < I_DN) { if (r < I_DN / 2) transpose_item<1>(MapIdent{(const float*)a.in[13], D, 0, 1 << 30, 1.f, WDN_SCALE}, FF, F.ws + WS_W0DOWN, 32, scr, r, F.lane); continue; } r -= I_DN;
#else
        if (r < I_DN) { transpose_item<0>(MapIdent{(const float*)a.in[13], D, 0, 1 << 30, 1.f, 1.f}, FF, (bf16*)(F.ws + WS_W0DOWN), 32, scr, r, F.lane); continue; } r -= I_DN;
#endif
#if PROJ1_I8
        {
            const int kb = r / 80, nb = r % 80; const float* W = (const float*)a.in[17] + (size_t)(64 * kb + (F.lane >> 5)) * N1 + 32 * nb + (F.lane & 31);
            float am = 0.f;
#pragma unroll
            for (int i = 0; i < 32; ++i) am = fmaxf(am, fabsf(W[(size_t)(2 * i) * N1]));
            am = fmaxf(am, __shfl_xor(am, 32));
            if (F.lane < 32) atomicMax((unsigned*)(F.ctl + CW_CMAX1) + 32 * nb + F.lane, __float_as_uint(am)); }
#else
        transpose_item<0>(MapIdent{(const float*)a.in[17], N1, 768, 2304, QSCALE, 1.f}, D, (bf16*)(F.ws + WS_W1IN), 80, scr, r, F.lane);
#endif
    }
    bf16* xn = (bf16*)(F.ws + WS_XN);
    for (int r = (part == 1 ? M : 0) + gw; r < (part == 2 ? M : M + 2 * MEMR); r += NGW) {
        const float* src; const float* g;
        if (r < M) { src = (const float*)a.in[0] + (size_t)r * D; g = (const float*)a.in[3]; }
        else if (r < M + MEMR) { src = (const float*)a.in[1] + (size_t)(r - M) * D; g = (const float*)a.in[4]; }
        else { src = (const float*)a.in[1] + (size_t)(r - M - MEMR) * D; g = (const float*)a.in[16]; }
        f32x4 v[4], gv[4]; ld_row_f32_nt(src, F.lane, v); ld_row_f32(g, F.lane, gv);
        const float rs = row_rstd(v);
#pragma unroll
        for (int j = 0; j < 4; ++j) v[j] = v[j] * rs * gv[j];
#if PROJ0_I8
        {   float am = 0.f;
#pragma unroll
            for (int j = 0; j < 4; ++j) am = fmaxf(fmaxf(am, fmaxf(fabsf(v[j][0]), fabsf(v[j][1]))), fmaxf(fabsf(v[j][2]), fabsf(v[j][3])));
#pragma unroll
            for (int o = 1; o < 64; o <<= 1) am = fmaxf(am, __shfl_xor(am, o));
            const float inv = am > 0.f ? 127.0f / am : 0.f;
#pragma unroll
            for (int j = 0; j < 4; ++j) *(unsigned*)((unsigned char*)xn + (size_t)r * D + 4 * F.lane + 256 * j) = pk4_i8(v[j][0] * inv, v[j][1] * inv, v[j][2] * inv, v[j][3] * inv);
            if (F.lane == 0) ((float*)(F.ws + WS_TAB + TAB_ROWSC0))[r] = am * (1.0f / 127.0f); }
#else
        st_row_bf16(xn + (size_t)r * D, F.lane, v);
#endif
    }
    float* rope = (float*)(F.ws + WS_ROPE); const int* pos = (const int*)a.in[2];
    if (part != 1)
    for (int idx = gw * 64 + F.lane; idx < M * 32; idx += NGW * 64) {
        const int m = idx >> 5, i = idx & 31;
        const float inv_freq = exp2f(-(float)i * (13.287712379549449f / 32.0f));
        const float ang = (float)pos[m] * inv_freq;
        const double rev = (double)ang * 0.15915494309189535; const float fr = (float)(rev - floor(rev));
        rope[(size_t)m * 64 + i] = __builtin_amdgcn_cosf(fr); rope[(size_t)m * 64 + 32 + i] = __builtin_amdgcn_sinf(fr);
    }
}

template <int XM> __device__ __forceinline__ void norm_res_tail(Frame& F, size_t m, f32x4 (&v)[4], f32x4 (&h)[4], const f32x4 (&gn)[4], bf16* xn, float* rowscale) {
    const float rs2 = row_rstd(h);
#pragma unroll
    for (int j = 0; j < 4; ++j) v[j] = h[j] * rs2 * gn[j];
    if (XM == 2) { float am = 0.f;
#pragma unroll
        for (int j = 0; j < 4; ++j) am = fmaxf(fmaxf(am, fmaxf(fabsf(v[j][0]), fabsf(v[j][1]))), fmaxf(fabsf(v[j][2]), fabsf(v[j][3])));
#pragma unroll
        for (int o = 1; o < 64; o <<= 1) am = fmaxf(am, __shfl_xor(am, o));
        const float inv = am > 0.f ? 127.0f / am : 0.f;
#pragma unroll
        for (int j = 0; j < 4; ++j) *(unsigned*)((unsigned char*)xn + m * D + 4 * F.lane + 256 * j) = pk4_i8(v[j][0] * inv, v[j][1] * inv, v[j][2] * inv, v[j][3] * inv);
        if (F.lane == 0) rowscale[m] = am * (1.0f / 127.0f); }
    else st_row_bf16(xn + m * D, F.lane, v);
}
template <int XM, bool HB> __device__ __forceinline__ void phase_norm_res(Frame& F, const bf16* mix, const void* hin_, const float* gpost, const float* gnext, bf16* xn, float* rowscale) {
    const float* hin = (const float*)hin_; const bf16* hinb = (const bf16*)hin_; bf16* res = (bf16*)(F.ws + WS_RES);
    f32x4 gp[4], gn[4]; ld_row_f32(gpost, F.lane, gp); ld_row_f32(gnext, F.lane, gn);
    for (int i = 0; i < 16; i += 2) { const size_t ma = (size_t)(128 * F.c + 16 * F.wave + i), mb = ma + 1;
        f32x4 va[4], ha[4], vb[4], hb[4]; ld_row_bf16_nt(mix + ma * D, F.lane, va); if (HB) ld_row_bf16_nt(hinb + ma * D, F.lane, ha); else ld_row_f32_nt(hin + ma * D, F.lane, ha); ld_row_bf16_nt(mix + mb * D, F.lane, vb); if (HB) ld_row_bf16_nt(hinb + mb * D, F.lane, hb); else ld_row_f32_nt(hin + mb * D, F.lane, hb);
        const float rsa = row_rstd(va), rsb = row_rstd(vb);
#pragma unroll
        for (int j = 0; j < 4; ++j) { ha[j] = ha[j] + va[j] * rsa * gp[j]; hb[j] = hb[j] + vb[j] * rsb * gp[j]; }
        st_row_bf16_nt(res + ma * D, F.lane, ha); st_row_bf16_nt(res + mb * D, F.lane, hb);
        norm_res_tail<XM>(F, ma, va, ha, gn, xn, rowscale); norm_res_tail<XM>(F, mb, vb, hb, gn, xn, rowscale); }
}
__device__ __forceinline__ void phase_route(const Args& a, Frame& F) {
    const bf16* mix = (const bf16*)(F.ws + WS_MIX); const float* wr = (const float*)a.in[22];
    int* tok_e = (int*)(F.ws + WS_TAB + TAB_TOKE); float* tok_w = (float*)(F.ws + WS_TAB + TAB_TOKW);
    int* woff = (int*)(F.ws + WS_TAB + TAB_WOFF); int* wgh = (int*)(F.ws + WS_TAB + TAB_WGH);
    f32x4 gp[4], gn[4]; ld_row_f32((const float*)a.in[20], F.lane, gp); ld_row_f32((const float*)a.in[21], F.lane, gn);
    unsigned long long cnt = 0ull;
    for (int i = 0; i < 16; ++i) { const size_t m = (size_t)(128 * F.c + 16 * F.wave + i);
        f32x4 v[4], h[4]; ld_row_bf16_nt(mix + m * D, F.lane, v); ld_row_bf16_nt((const bf16*)(F.ws + WS_RES) + m * D, F.lane, h);
        const float rs = row_rstd(v);
#pragma unroll
        for (int j = 0; j < 4; ++j) h[j] = h[j] + v[j] * rs * gp[j];
        st_row_bf16_nt((bf16*)(F.ws + WS_RES) + m * D, F.lane, h);
        const float rs2 = row_rstd(h);
        float lg[8];
#pragma unroll
        for (int e = 0; e < 8; ++e) lg[e] = 0.f;
#pragma unroll
        for (int j = 0; j < 4; ++j) { const f32x4 x = h[j] * rs2 * gn[j];
#if MOE_FP8
            *(unsigned*)(F.ws + WS_XN8U + m * D + 4 * F.lane + 256 * j) = pg8::pk4_fp8(x[0] * XS_SCALE, x[1] * XS_SCALE, x[2] * XS_SCALE, x[3] * XS_SCALE);
#endif
#pragma unroll
            for (int q = 0; q < 4; ++q) { const float* wp = wr + (size_t)(4 * F.lane + 256 * j + q) * 8; const f32x4 w0 = *(const f32x4*)wp, w1 = *(const f32x4*)(wp + 4);
                lg[0] += x[q] * w0[0]; lg[1] += x[q] * w0[1]; lg[2] += x[q] * w0[2]; lg[3] += x[q] * w0[3]; lg[4] += x[q] * w1[0]; lg[5] += x[q] * w1[1]; lg[6] += x[q] * w1[2]; lg[7] += x[q] * w1[3]; } }
#pragma unroll
        for (int e = 0; e < 8; ++e) lg[e] = wave_sum(lg[e]);
        int e0 = 0; float v0 = lg[0];
#pragma unroll
        for (int e = 1; e < 8; ++e) if (lg[e] > v0) { v0 = lg[e]; e0 = e; }
        int e1 = -1; float v1 = -INFINITY;
#pragma unroll
        for (int e = 0; e < 8; ++e) if (e != e0 && lg[e] > v1) { v1 = lg[e]; e1 = e; }
        if (e1 < 0) e1 = (e0 + 1) & 7;
        const float ex = __expf(v1 - v0), w0 = 1.0f / (1.0f + ex), w1 = ex * w0;
        const unsigned r0 = (unsigned)(cnt >> (8 * e0)) & 0xffu; cnt += 1ull << (8 * e0);
        const unsigned r1 = (unsigned)(cnt >> (8 * e1)) & 0xffu; cnt += 1ull << (8 * e1);
        if (F.lane == 0) { tok_e[m] = e0 | (e1 << 4) | (int)(r0 << 8) | (int)(r1 << 16); tok_w[2 * m] = w0; tok_w[2 * m + 1] = w1; } }
    LAS unsigned* wh = (LAS unsigned*)(F.lds + RING_OFF);
    if (F.lane < 8) wh[F.wave * 8 + F.lane] = (unsigned)(cnt >> (8 * F.lane)) & 0xffu;
    __syncthreads();
    if (F.tid < 8) { unsigned run = 0u;
        for (int w = 0; w < 8; ++w) { woff[(F.c * 8 + w) * 8 + F.tid] = (int)run; run += wh[w * 8 + F.tid]; }
        wgh[F.c * 8 + F.tid] = (int)run; }
    __syncthreads();
}
__device__ __forceinline__ void phase_permute(const Args& a, Frame& F) {
    const int* tok_e = (const int*)(F.ws + WS_TAB + TAB_TOKE); const float* tok_w = (const float*)(F.ws + WS_TAB + TAB_TOKW);
    int* tok_slot = (int*)(F.ws + WS_TAB + TAB_TOKSLOT); const int* woff = (const int*)(F.ws + WS_TAB + TAB_WOFF); const int* wgh = (const int*)(F.ws + WS_TAB + TAB_WGH);
    int* est_g = (int*)(F.ws + WS_TAB + TAB_EST); float* slot_w = (float*)(F.ws + WS_TAB + TAB_SLOTW);
    LAS int* part = (LAS int*)(F.lds + RING_OFF);
    LAS int* basew = (LAS int*)(F.lds + RING_OFF + 1024);
    if (F.tid < 256) {
        int hv[8];
#pragma unroll
        for (int e = 0; e < 8; ++e) hv[e] = wgh[F.tid * 8 + e];
#pragma unroll
        for (int e = 0; e < 8; ++e) { const int tot = wave_sum_i(hv[e]), pre = wave_sum_i(F.tid < F.c ? hv[e] : 0);
            if (F.lane == 0) { part[F.wave * 16 + e] = tot; part[F.wave * 16 + 8 + e] = pre; } }
    }
    __syncthreads();
    int est[9], pre[8]; est[0] = 0;
#pragma unroll
    for (int e = 0; e < 8; ++e) { const int tot = part[e] + part[16 + e] + part[32 + e] + part[48 + e]; pre[e] = part[8 + e] + part[24 + e] + part[40 + e] + part[56 + e]; est[e + 1] = est[e] + ((tot + 255) & ~255); }
    if (F.c == 0 && F.tid == 0) {
#pragma unroll
        for (int k = 0; k < 9; ++k) est_g[k] = est[k];
    }
    if (F.lane < 8) { int b = 0;
#pragma unroll
        for (int e = 0; e < 8; ++e) if (F.lane == e) b = est[e] + pre[e];
        basew[F.wave * 8 + F.lane] = b + woff[(F.c * 8 + F.wave) * 8 + F.lane]; }
    LDS_WAIT(); asm volatile("" ::: "memory");
    bf16* xs = (bf16*)(F.ws + WS_XS);
#if MOE_FP8
    {
        const size_t mb = (size_t)(128 * F.c + 16 * F.wave);
        unsigned w[16][4]; int sa[16], sb[16];
#pragma unroll
        for (int i = 0; i < 16; ++i) {
#pragma unroll
            for (int j = 0; j < 4; ++j) w[i][j] = __builtin_nontemporal_load((const unsigned*)(F.ws + WS_XN8U + (mb + i) * D + 4 * F.lane + 256 * j)); }
#pragma unroll
        for (int i = 0; i < 16; ++i) { const size_t m = mb + i;
            const int te = tok_e[m]; const int e0 = te & 15, e1 = (te >> 4) & 15, r0 = (te >> 8) & 255, r1 = (te >> 16) & 255;
            sa[i] = basew[F.wave * 8 + e0] + r0; sb[i] = basew[F.wave * 8 + e1] + r1;
            if (F.lane == 0) { tok_slot[2 * m] = sa[i]; tok_slot[2 * m + 1] = sb[i]; slot_w[sa[i]] = tok_w[2 * m]; slot_w[sb[i]] = tok_w[2 * m + 1]; } }
#pragma unroll
        for (int i = 0; i < 16; ++i) {
#pragma unroll
            for (int j = 0; j < 4; ++j) { *(unsigned*)((unsigned char*)xs + (size_t)sa[i] * D + 4 * F.lane + 256 * j) = w[i][j]; *(unsigned*)((unsigned char*)xs + (size_t)sb[i] * D + 4 * F.lane + 256 * j) = w[i][j]; } }
    }
#else
    f32x4 gn[4]; ld_row_f32((const float*)a.in[21], F.lane, gn);
    for (int i = 0; i < 16; ++i) { const size_t m = (size_t)(128 * F.c + 16 * F.wave + i);
        const int te = tok_e[m]; const int e0 = te & 15, e1 = (te >> 4) & 15, r0 = (te >> 8) & 255, r1 = (te >> 16) & 255;
        const int s0 = basew[F.wave * 8 + e0] + r0, s1 = basew[F.wave * 8 + e1] + r1;
        if (F.lane == 0) { tok_slot[2 * m] = s0; tok_slot[2 * m + 1] = s1; slot_w[s0] = tok_w[2 * m]; slot_w[s1] = tok_w[2 * m + 1]; }
        f32x4 h[4]; ld_row_bf16((const bf16*)(F.ws + WS_RES) + m * D, F.lane, h);
        const float rs = row_rstd(h);
#pragma unroll
        for (int j = 0; j < 4; ++j) h[j] = h[j] * rs * gn[j];
        st_row_bf16(xs + (size_t)s0 * D, F.lane, h); st_row_bf16(xs + (size_t)s1 * D, F.lane, h); }
#endif
    __syncthreads();
    LAS float* scr = (LAS float*)(F.lds + RING_OFF + F.wave * 16384);
    const int gw = F.c * NWAVES + F.wave, NGW = F.G * NWAVES;
#if MOE_FP8
    constexpr int I_GU = 8 * 224, I_DN = 28 * 32, I_E = I_GU + I_DN;
    for (int it = gw; it < NEXP * I_E; it += NGW) { const int e = it / I_E, r = it % I_E;
        if (r < I_GU) transpose_item<1>(MapGU{(const float*)a.in[23] + (size_t)e * D * FF, (const float*)a.in[24] + (size_t)e * D * FF, WGU_SCALE}, D, F.ws + WS_W1GU + (size_t)e * 2 * FF * D, 224, scr, r, F.lane);
        else transpose_item<1>(MapIdent{(const float*)a.in[25] + (size_t)e * FF * D, D, 0, 1 << 30, 1.f, WDN_SCALE}, FF, F.ws + WS_W1DOWN + (size_t)e * D * FF, 32, scr, r - I_GU, F.lane); }
#else
    constexpr int I_GU = 16 * 224, I_DN = 56 * 32, I_E = I_GU + I_DN;
    for (int it = gw; it < NEXP * I_E; it += NGW) { const int e = it / I_E, r = it % I_E;
        if (r < I_GU) transpose_item<0>(MapGU{(const float*)a.in[23] + (size_t)e * D * FF, (const float*)a.in[24] + (size_t)e * D * FF, 1.f}, D, (bf16*)(F.ws + WS_W1GU) + (size_t)e * 2 * FF * D, 224, scr, r, F.lane);
        else transpose_item<0>(MapIdent{(const float*)a.in[25] + (size_t)e * FF * D, D, 0, 1 << 30, 1.f, 1.f}, FF, (bf16*)(F.ws + WS_W1DOWN) + (size_t)e * D * FF, 32, scr, r - I_GU, F.lane); }
#endif
}
__device__ __forceinline__ int build_expert_table(Frame& F) {
    const GAS int* est_g = vptr((const int*)(F.ws + WS_TAB + TAB_EST));
    int est[9];
#pragma unroll
    for (int k = 0; k < 9; ++k) est[k] = est_g[k];
    LAS unsigned char* tab = F.lds + ETAB_OFF;
    if (F.tid < TMAX) { const int r = F.tid * 256; int e = 0;
#pragma unroll
        for (int k = 1; k < 8; ++k) e += (r >= est[k]) ? 1 : 0;
        tab[F.tid] = (unsigned char)e; }
    __syncthreads();
    return __builtin_amdgcn_readfirstlane(est[8]) >> 8;
}
__device__ __forceinline__ void final_row(const bf16* ys, size_t m, int s0, int s1, const f32x4 (&gp)[4], Frame& F, bool poison) {
    const float qnan = __builtin_nanf("");
    f32x4 y0[4], y1[4], h[4]; ld_row_bf16_nt(ys + (size_t)s0 * D, F.lane, y0); ld_row_bf16_nt(ys + (size_t)s1 * D, F.lane, y1); ld_row_bf16_nt((const bf16*)(F.ws + WS_RES) + m * D, F.lane, h);
#pragma unroll
    for (int j = 0; j < 4; ++j) y0[j] = y0[j] + y1[j];
    const float rs = row_rstd(y0);
#pragma unroll
    for (int j = 0; j < 4; ++j) { h[j] = h[j] + y0[j] * rs * gp[j]; if (poison) h[j] = (f32x4){qnan, qnan, qnan, qnan}; }
    st_row_f32_nt(F.out + m * D, F.lane, h);
}
__device__ __forceinline__ void final_row2(const bf16* ys, size_t ma, int a0, int a1, size_t mb, int b0, int b1, const f32x4 (&gp)[4], Frame& F, bool poison) {
    const float qnan = __builtin_nanf("");
    f32x4 ya0[4], ya1[4], ha[4], yb0[4], yb1[4], hb[4];
    ld_row_bf16_nt(ys + (size_t)a0 * D, F.lane, ya0); ld_row_bf16_nt(ys + (size_t)a1 * D, F.lane, ya1); ld_row_bf16_nt((const bf16*)(F.ws + WS_RES) + ma * D, F.lane, ha);
    ld_row_bf16_nt(ys + (size_t)b0 * D, F.lane, yb0); ld_row_bf16_nt(ys + (size_t)b1 * D, F.lane, yb1); ld_row_bf16_nt((const bf16*)(F.ws + WS_RES) + mb * D, F.lane, hb);
#pragma unroll
    for (int j = 0; j < 4; ++j) { ya0[j] = ya0[j] + ya1[j]; yb0[j] = yb0[j] + yb1[j]; }
    const float rsa = row_rstd(ya0), rsb = row_rstd(yb0);
#pragma unroll
    for (int j = 0; j < 4; ++j) { ha[j] = ha[j] + ya0[j] * rsa * gp[j]; hb[j] = hb[j] + yb0[j] * rsb * gp[j]; if (poison) { ha[j] = (f32x4){qnan, qnan, qnan, qnan}; hb[j] = ha[j]; } }
    st_row_f32_nt(F.out + ma * D, F.lane, ha); st_row_f32_nt(F.out + mb * D, F.lane, hb);
}
__device__ __forceinline__ void phase_final(const Args& a, Frame& F, bool poison, int mode, int nskip) {
    const bf16* ys = (const bf16*)(F.ws + WS_YS); const int* tok_slot = (const int*)(F.ws + WS_TAB + TAB_TOKSLOT);
    f32x4 gp[4]; ld_row_f32((const float*)a.in[26], F.lane, gp);
#if MOE_FP8
    if (mode == 0) { const int stride = (F.G - nskip) * NWAVES;
        for (int mi = (F.c - nskip) * NWAVES + F.wave; mi < M; mi += 2 * stride) { const size_t ma = (size_t)mi, mb = (size_t)(mi + stride); const bool hb = mi + stride < M;
            const int a0 = tok_slot[2 * ma], a1 = tok_slot[2 * ma + 1]; int b0 = 0, b1 = 0; if (hb) { b0 = tok_slot[2 * mb]; b1 = tok_slot[2 * mb + 1]; }
            const bool da = !(a0 >= TAIL_SLOT0 || a1 >= TAIL_SLOT0), db = hb && !(b0 >= TAIL_SLOT0 || b1 >= TAIL_SLOT0);
            if (da && db) final_row2(ys, ma, a0, a1, mb, b0, b1, gp, F, poison);
            else { if (da) final_row(ys, ma, a0, a1, gp, F, poison); if (db) final_row(ys, mb, b0, b1, gp, F, poison); } } }
    else {
        for (int i = 0; i < 16; ++i) { const size_t m = (size_t)(128 * F.c + 16 * F.wave + i); const int s0 = tok_slot[2 * m], s1 = tok_slot[2 * m + 1];
            if (!(s0 >= TAIL_SLOT0 || s1 >= TAIL_SLOT0)) continue;
            final_row(ys, m, s0, s1, gp, F, poison); } }
#else
    for (int i = 0; i < 16; ++i) { const size_t m = (size_t)(128 * F.c + 16 * F.wave + i); final_row(ys, m, tok_slot[2 * m], tok_slot[2 * m + 1], gp, F, poison); }
#endif
}

namespace att {
using bf16x8 = __attribute__((ext_vector_type(8))) short;
using s16x4 = __attribute__((ext_vector_type(4))) short;
using f32x16 = __attribute__((ext_vector_type(16))) float;
using u32x4 = __attribute__((ext_vector_type(4))) unsigned;
typedef LAS const char* lds_cptr;
constexpr int SLOTB = 8192;
constexpr int L_K = 0, L_V = 4 * SLOTB, L_WS = 8 * SLOTB, L_OST = L_WS + 8 * 256, L_FLAG = L_OST + 8 * 4096, L_END = L_FLAG + 64;
static_assert(L_END <= RING_BYTES, "attention LDS map");
#define SBAR() __builtin_amdgcn_sched_barrier(0)
#define WAIT_BAR(N) asm volatile("s_waitcnt vmcnt(" #N ") lgkmcnt(0)\n\ts_barrier" ::: "memory")
#define WAIT_BAR_L() asm volatile("s_waitcnt lgkmcnt(0)\n\ts_barrier" ::: "memory")
__device__ __forceinline__ int crow(int r, int hi) { return (r & 3) + 8 * (r >> 2) + 4 * hi; }
__device__ __forceinline__ void glds16(const void* gsrc, unsigned lds_dst) { unsigned keep;
    asm volatile("s_mov_b32 %0, m0\n\ts_mov_b32 m0, %2\n\ts_nop 0\n\tglobal_load_lds_dwordx4 %1, off\n\ts_mov_b32 m0, %0" : "=&s"(keep) : "v"(gsrc), "s"(lds_dst) : "memory"); }
__device__ __forceinline__ unsigned cvtpk(float lo, float hi) { unsigned r; asm volatile("v_cvt_pk_bf16_f32 %0, %1, %2" : "=v"(r) : "v"(lo), "v"(hi)); return r; }
__device__ __forceinline__ float swap_max(float m) { auto rr = __builtin_amdgcn_permlane32_swap(__float_as_uint(m), __float_as_uint(m), false, false); return fmaxf(__uint_as_float(rr[0]), __uint_as_float(rr[1])); }
__device__ __forceinline__ float swap_sum(float m) { auto rr = __builtin_amdgcn_permlane32_swap(__float_as_uint(m), __float_as_uint(m), false, false); return __uint_as_float(rr[0]) + __uint_as_float(rr[1]); }

struct KV { const bf16* K; const bf16* V; int ld; };
__device__ __forceinline__ void dma_k(const KV& kv, int key0, unsigned lds0, int slot, int wid, int lane) {
    glds16(kv.K + (size_t)(key0 + lane) * kv.ld + wid * 8, (unsigned)__builtin_amdgcn_readfirstlane(lds0 + L_K + slot * SLOTB + wid * 1024)); }
__device__ __forceinline__ void dma_v(const KV& kv, int key0, unsigned lds0, int slot, int wid, int lane) {
    glds16(kv.V + (size_t)(key0 + 16 * (wid & 3) + (lane >> 2)) * kv.ld + (wid >> 2) * 32 + (lane & 3) * 8, (unsigned)__builtin_amdgcn_readfirstlane(lds0 + L_V + slot * SLOTB + wid * 1024)); }
__device__ __forceinline__ void load_q(bf16x8 (&qr)[4], const bf16* Qrow0, int ld, int r32, int hi) {
#pragma unroll
    for (int d0 = 0; d0 < 4; ++d0) qr[d0] = *(const bf16x8*)(Qrow0 + (size_t)r32 * ld + d0 * 16 + hi * 8);
}
__device__ __forceinline__ void qkt(f32x16& p0, f32x16& p1, lds_cptr Kslot, const bf16x8 (&qr)[4], int r32, int hi) {
    const lds_cptr kb = Kslot + hi * 1024 + r32 * 16;
    f32x16 z0 = f32x16{}, z1 = f32x16{};
#pragma unroll
    for (int d0 = 0; d0 < 4; ++d0) {
        const bf16x8 b0 = *(LAS const bf16x8*)(kb + d0 * 2048);
        const bf16x8 b1 = *(LAS const bf16x8*)(kb + d0 * 2048 + 512);
        z0 = __builtin_amdgcn_mfma_f32_32x32x16_bf16(b0, qr[d0], z0, 0, 0, 0); z1 = __builtin_amdgcn_mfma_f32_32x32x16_bf16(b1, qr[d0], z1, 0, 0, 0); }
    p0 = z0; p1 = z1;
}
__device__ __forceinline__ void pv(f32x16 (&o)[2], int vb, bf16x8 pa0, bf16x8 pa1, bf16x8 pa2, bf16x8 pa3) {
#pragma unroll
    for (int d0 = 0; d0 < 2; ++d0) { s16x4 lo[4], hi[4];
#pragma unroll
        for (int ks = 0; ks < 4; ++ks) {
            asm volatile("ds_read_b64_tr_b16 %0,%1 offset:%c2" : "=&v"(lo[ks]) : "v"(vb), "i"(d0 * 4096 + ks * 1024) : "memory");
            asm volatile("ds_read_b64_tr_b16 %0,%1 offset:%c2" : "=&v"(hi[ks]) : "v"(vb), "i"(d0 * 4096 + ks * 1024 + 512) : "memory"); }
        asm volatile("s_waitcnt lgkmcnt(0)" ::: "memory"); SBAR();
#define ATT_PK(k) (bf16x8){lo[k][0], lo[k][1], lo[k][2], lo[k][3], hi[k][0], hi[k][1], hi[k][2], hi[k][3]}
        o[d0] = __builtin_amdgcn_mfma_f32_32x32x16_bf16(pa0, ATT_PK(0), o[d0], 0, 0, 0);
        o[d0] = __builtin_amdgcn_mfma_f32_32x32x16_bf16(pa1, ATT_PK(1), o[d0], 0, 0, 0);
        o[d0] = __builtin_amdgcn_mfma_f32_32x32x16_bf16(pa2, ATT_PK(2), o[d0], 0, 0, 0);
        o[d0] = __builtin_amdgcn_mfma_f32_32x32x16_bf16(pa3, ATT_PK(3), o[d0], 0, 0, 0);
#undef ATT_PK
    }
}
__device__ __forceinline__ void pack_p(const f32x16& p0, const f32x16& p1, bf16x8& a0, bf16x8& a1, bf16x8& a2, bf16x8& a3) {
    u32x4 w0 = (u32x4){cvtpk(p0[0], p0[1]), cvtpk(p0[2], p0[3]), cvtpk(p0[4], p0[5]), cvtpk(p0[6], p0[7])}, w1 = (u32x4){cvtpk(p0[8], p0[9]), cvtpk(p0[10], p0[11]), cvtpk(p0[12], p0[13]), cvtpk(p0[14], p0[15])};
    u32x4 w2 = (u32x4){cvtpk(p1[0], p1[1]), cvtpk(p1[2], p1[3]), cvtpk(p1[4], p1[5]), cvtpk(p1[6], p1[7])}, w3 = (u32x4){cvtpk(p1[8], p1[9]), cvtpk(p1[10], p1[11]), cvtpk(p1[12], p1[13]), cvtpk(p1[14], p1[15])};
    a0 = __builtin_bit_cast(bf16x8, w0); a1 = __builtin_bit_cast(bf16x8, w1); a2 = __builtin_bit_cast(bf16x8, w2); a3 = __builtin_bit_cast(bf16x8, w3);
}
__device__ __forceinline__ void store_o(const f32x16 (&o)[2], float l_row, bool normalize, bf16* Orow0, int ldo, LAS unsigned char* shm, int wid, int lane, int r32, int hi) {
    LAS float* wsf = (LAS float*)(shm + L_WS) + wid * 64;
    float rli[16];
    if (normalize) { if (hi == 0) wsf[32 + r32] = l_row; asm volatile("s_waitcnt lgkmcnt(0)" ::: "memory");
#pragma unroll
        for (int r = 0; r < 16; ++r) rli[r] = __builtin_amdgcn_rcpf(wsf[32 + crow(r, hi)]); }
    else {
#pragma unroll
        for (int r = 0; r < 16; ++r) rli[r] = 1.0f; }
    LAS bf16* stg = (LAS bf16*)(shm + L_OST) + wid * 2048;
#pragma unroll
    for (int r = 0; r < 16; ++r) { const int orow = crow(r, hi);
#pragma unroll
        for (int d0 = 0; d0 < 2; ++d0) stg[orow * 64 + d0 * 32 + r32] = (bf16)f2bf(o[d0][r] * rli[r]); }
    asm volatile("s_waitcnt lgkmcnt(0)" ::: "memory");
#pragma unroll
    for (int i = 0; i < 4; ++i) { const int row = i * 8 + (lane >> 3), ch = lane & 7; const u32x4 v = *(LAS const u32x4*)(stg + row * 64 + ch * 8); *(u32x4*)(Orow0 + (size_t)row * ldo + ch * 8) = v; }
    asm volatile("s_waitcnt lgkmcnt(0)" ::: "memory");
}

template <bool MASK> __device__ __forceinline__ void softmax_task(LAS unsigned char* shm, unsigned lds0, const bf16x8 (&qr)[4], int jlo, int jhi, int tq, float m_init, bool has_sink,
                                                                  f32x16 (&o)[2], float& l_out, int lane, int r32, int hi) {
    const lds_cptr shm3 = (lds_cptr)shm;
    const int vb0 = (int)(lds0 + L_V) + ((lane >> 4) & 1) * 32 + (lane & 3) * 8 + (4 * hi + ((lane & 15) >> 2)) * 64;
    float m = m_init;
    for (int j = jlo; j <= jhi; ++j) { f32x16 p0, p1; qkt(p0, p1, shm3 + L_K + j * SLOTB, qr, r32, hi);
        float a = -INFINITY;
#pragma unroll
        for (int r = 0; r < 16; ++r) { const int kk = 64 * j + crow(r, hi); float s0 = p0[r], s1 = p1[r];
            if (MASK) { if (kk < tq + 1 || kk > tq + 128) s0 = -INFINITY; if (kk + 32 < tq + 1 || kk + 32 > tq + 128) s1 = -INFINITY; }
            a = fmaxf(a, fmaxf(s0, s1)); }
        m = fmaxf(m, a); }
    m = swap_max(m);
    if (!(m > -1e30f)) m = 0.f;
    float l = 0.f; o[0] = f32x16{}; o[1] = f32x16{};
    for (int j = jlo; j <= jhi; ++j) { f32x16 p0, p1; qkt(p0, p1, shm3 + L_K + j * SLOTB, qr, r32, hi);
#pragma unroll
        for (int r = 0; r < 16; ++r) { const int kk = 64 * j + crow(r, hi); float s0 = p0[r], s1 = p1[r];
            if (MASK) { if (kk < tq + 1 || kk > tq + 128) s0 = -INFINITY; if (kk + 32 < tq + 1 || kk + 32 > tq + 128) s1 = -INFINITY; }
            p0[r] = __builtin_amdgcn_exp2f(s0 - m); p1[r] = __builtin_amdgcn_exp2f(s1 - m); l += p0[r] + p1[r]; }
        bf16x8 a0, a1, a2, a3; pack_p(p0, p1, a0, a1, a2, a3);
        pv(o, vb0 + j * SLOTB, a0, a1, a2, a3); }
    l = swap_sum(l);
    if (has_sink) l += __builtin_amdgcn_exp2f(m_init - m);
    l_out = l;
}
__device__ __forceinline__ void swa_task_online(LAS unsigned char* shm, unsigned lds0, const bf16x8 (&qr)[4], int jlo, int jhi, int jmid, int tq, float m_init,
                                                f32x16 (&o)[2], float& l_out, int wid, int lane, int r32, int hi) {
    const lds_cptr shm3 = (lds_cptr)shm;
    const int vb0 = (int)(lds0 + L_V) + ((lane >> 4) & 1) * 32 + (lane & 3) * 8 + (4 * hi + ((lane & 15) >> 2)) * 64;
    LAS float* wsf = (LAS float*)(shm + L_WS) + wid * 64;
    float m = m_init, l = 0.f; o[0] = f32x16{}; o[1] = f32x16{};
    for (int j = jlo; j <= jhi; ++j) { f32x16 p0, p1; qkt(p0, p1, shm3 + L_K + j * SLOTB, qr, r32, hi);
        if (j != jmid) {
#pragma unroll
            for (int r = 0; r < 16; ++r) { const int kk = 64 * j + crow(r, hi);
                if (kk < tq + 1 || kk > tq + 128) p0[r] = -INFINITY; if (kk + 32 < tq + 1 || kk + 32 > tq + 128) p1[r] = -INFINITY; } }
        float a = -INFINITY;
#pragma unroll
        for (int r = 0; r < 16; ++r) a = fmaxf(a, fmaxf(p0[r], p1[r]));
        const float mn = fmaxf(m, swap_max(a)), al = __builtin_amdgcn_exp2f(m - mn); m = mn;
        if (hi == 0) wsf[r32] = al;
        float ps = 0.f;
#pragma unroll
        for (int r = 0; r < 16; ++r) { p0[r] = __builtin_amdgcn_exp2f(p0[r] - mn); p1[r] = __builtin_amdgcn_exp2f(p1[r] - mn); ps += p0[r] + p1[r]; }
        l = l * al + ps;
        asm volatile("s_waitcnt lgkmcnt(0)" ::: "memory");
#pragma unroll
        for (int g = 0; g < 4; ++g) { const f32x4 f = *(LAS const f32x4*)(wsf + 8 * g + 4 * hi);
#pragma unroll
            for (int k = 0; k < 4; ++k) { o[0][4 * g + k] *= f[k]; o[1][4 * g + k] *= f[k]; } }
        bf16x8 a0, a1, a2, a3; pack_p(p0, p1, a0, a1, a2, a3);
        pv(o, vb0 + j * SLOTB, a0, a1, a2, a3); }
    l = swap_sum(l) + __builtin_amdgcn_exp2f(m_init - m);
    l_out = l;
}
__device__ __forceinline__ void swa_phase(Frame& F, const float* sinks) {
    const bf16* P = (const bf16*)(F.ws + WS_PROJ); bf16* O = (bf16*)(F.ws + WS_ATT);
    LAS unsigned char* shm = F.lds + RING_OFF; const unsigned lds0 = (unsigned)(size_t)shm;
    const int lane = F.lane, r32 = lane & 31, hi = lane >> 5, wid = F.wave;
    for (int u = F.c; u < BATCH * NKV0 * 16; u += F.G) {
        const int qb = u & 15, kvh = (u >> 4) % NKV0, b = u / (16 * NKV0);
        const size_t row0 = (size_t)b * SEQ;
        KV kv{P + row0 * N0 + P0_K + kvh * 64, P + row0 * N0 + P0_V + kvh * 64, N0};
        const int jfirst = qb == 0 ? 2 : 0;
        for (int j = jfirst; j < 4; ++j) { dma_k(kv, 128 * qb - 128 + 64 * j, lds0, j, wid, lane); dma_v(kv, 128 * qb - 128 + 64 * j, lds0, j, wid, lane); }
        bf16x8 qa[4], qb2[4];
        const int ta = wid, tb = wid + 8;
        const int ha = 4 * kvh + (ta >> 2), hb = 4 * kvh + (tb >> 2), q0a = 32 * (ta & 3), q0b = 32 * (tb & 3);
        load_q(qa, P + (row0 + 128 * qb + q0a) * N0 + P0_Q + ha * 64, N0, r32, hi);
        load_q(qb2, P + (row0 + 128 * qb + q0b) * N0 + P0_Q + hb * 64, N0, r32, hi);
        WAIT_BAR(0);
        {   const int jlo = (q0a + 1) >> 6, jhi = (q0a + 159) >> 6; f32x16 o[2]; float l;
            swa_task_online(shm, lds0, qa, jlo < jfirst ? jfirst : jlo, jhi, jlo + 1, q0a + r32, sinks[ha] * LOG2E, o, l, wid, lane, r32, hi);
            store_o(o, l, true, O + (row0 + 128 * qb + q0a) * D + ha * 64, D, shm, wid, lane, r32, hi); }
        {   const int jlo = (q0b + 1) >> 6, jhi = (q0b + 159) >> 6; f32x16 o[2]; float l;
            swa_task_online(shm, lds0, qb2, jlo < jfirst ? jfirst : jlo, jhi, jlo + 1, q0b + r32, sinks[hb] * LOG2E, o, l, wid, lane, r32, hi);
            store_o(o, l, true, O + (row0 + 128 * qb + q0b) * D + hb * 64, D, shm, wid, lane, r32, hi); }
        WAIT_BAR(0);
    }
}
__device__ __forceinline__ void cross_phase(Frame& F, const bf16* P, int ldp, int qoff, const bf16* KVm) {
    bf16* O = (bf16*)(F.ws + WS_ATT);
    LAS unsigned char* shm = F.lds + RING_OFF; const unsigned lds0 = (unsigned)(size_t)shm;
    const int lane = F.lane, r32 = lane & 31, hi = lane >> 5, wid = F.wave;
    const int per = (BATCH * NCH * 8 + F.G - 1) / F.G; int loaded = -1;
    for (int u = F.c * per; u < (F.c + 1) * per && u < BATCH * NCH * 8; ++u) {
        const int qb = u & 7, pair = u >> 3, c = pair & 3, b = pair >> 2;
        KV kv{KVm + (size_t)b * MEML * 512 + c * 64, KVm + (size_t)b * MEML * 512 + 256 + c * 64, 512};
        if (pair != loaded) { for (int j = 0; j < 4; ++j) { dma_k(kv, 64 * j, lds0, j, wid, lane); dma_v(kv, 64 * j, lds0, j, wid, lane); } loaded = pair; }
        const size_t qrow = (size_t)b * SEQ + 256 * qb + 32 * wid;
        bf16x8 qr[4]; load_q(qr, P + qrow * ldp + qoff + c * 64, ldp, r32, hi);
        WAIT_BAR(0);
        f32x16 o[2]; float l;
        softmax_task<false>(shm, lds0, qr, 0, 3, 0, -INFINITY, false, o, l, lane, r32, hi);
        store_o(o, l, true, O + qrow * D + NHS * 64 + c * 64, D, shm, wid, lane, r32, hi);
        WAIT_BAR(0);
    }
}
#undef SBAR
}
namespace att {
#define SBAR() __builtin_amdgcn_sched_barrier(0)
template <bool DIAG> __device__ __forceinline__ void sb_tile(f32x16& p0, f32x16& p1, int key0, int t, float& C, int hi) {
    f32x16 r0, r1;
#pragma unroll
    for (int r = 0; r < 16; ++r) { const float u = __builtin_amdgcn_exp2f(__builtin_fminf(p0[r], 64.0f)); float rr = __builtin_amdgcn_rcpf(1.0f + u), be = u * rr; if (DIAG && key0 + crow(r, hi) >= t) { rr = 1.f; be = 0.f; } r0[r] = rr; p0[r] = be; }
    SBAR();
#pragma unroll
    for (int r = 0; r < 16; ++r) { const float u = __builtin_amdgcn_exp2f(__builtin_fminf(p1[r], 64.0f)); float rr = __builtin_amdgcn_rcpf(1.0f + u), be = u * rr; if (DIAG && key0 + 32 + crow(r, hi) >= t) { rr = 1.f; be = 0.f; } r1[r] = rr; p1[r] = be; }
    SBAR();
    float G[16];
#pragma unroll
    for (int i = 0; i < 4; ++i) {
        const float g0 = (r0[4 * i] * r0[4 * i + 1]) * (r0[4 * i + 2] * r0[4 * i + 3]), g1 = (r1[4 * i] * r1[4 * i + 1]) * (r1[4 * i + 2] * r1[4 * i + 3]);
        auto x0 = __builtin_amdgcn_permlane32_swap(__float_as_uint(g0), __float_as_uint(g0), false, false); G[2 * i] = __uint_as_float(x0[0]); G[2 * i + 1] = __uint_as_float(x0[1]);
        auto x1 = __builtin_amdgcn_permlane32_swap(__float_as_uint(g1), __float_as_uint(g1), false, false); G[8 + 2 * i] = __uint_as_float(x1[0]); G[8 + 2 * i + 1] = __uint_as_float(x1[1]); }
    float E[16]; E[15] = C;
#pragma unroll
    for (int g = 14; g >= 0; --g) E[g] = E[g + 1] * G[g + 1];
    C = E[0] * G[0];
    SBAR();
#pragma unroll
    for (int i = 0; i < 4; ++i) {
        { float e = hi ? E[2 * i + 1] : E[2 * i];
#pragma unroll
          for (int j = 3; j >= 0; --j) { const float w = p0[4 * i + j] * e; e *= r0[4 * i + j]; p0[4 * i + j] = w; } }
        { float e = hi ? E[8 + 2 * i + 1] : E[8 + 2 * i];
#pragma unroll
          for (int j = 3; j >= 0; --j) { const float w = p1[4 * i + j] * e; e *= r1[4 * i + j]; p1[4 * i + j] = w; } }
    }
}
__device__ __forceinline__ void sb_unit(Frame& F, int b, int h, int qb) {
    const bf16* P = (const bf16*)(F.ws + WS_PROJ); bf16* O = (bf16*)(F.ws + WS_ATT);
    LAS unsigned char* shm = F.lds + RING_OFF; const unsigned lds0 = (unsigned)(size_t)shm; const lds_cptr shm3 = (lds_cptr)shm;
    const int lane = F.lane, r32 = lane & 31, hi = lane >> 5, wid = F.wave;
    const size_t row0 = (size_t)b * SEQ;
    KV kv{P + row0 * N1 + P1_K + h * 64, P + row0 * N1 + P1_V + h * 64, N1};
    const int NT = 4 * qb + 4, T0 = 256 * qb + 32 * wid, t = T0 + r32;
    const int vb0 = (int)(lds0 + L_V) + ((lane >> 4) & 1) * 32 + (lane & 3) * 8 + (4 * hi + ((lane & 15) >> 2)) * 64;
    LAS unsigned* flag = (LAS unsigned*)(shm + L_FLAG);
    dma_k(kv, 64 * (NT - 1), lds0, 0, wid, lane); dma_v(kv, 64 * (NT - 1), lds0, 0, wid, lane);
    bf16x8 qr[4]; load_q(qr, P + (row0 + T0) * N1 + P1_Q + h * 64, N1, r32, hi);
    f32x16 o[2]; o[0] = f32x16{}; o[1] = f32x16{};
    float C = 1.f; bool mydone = false;
    for (int i = 0; i < NT; ++i) {
        const int kt = NT - 1 - i, sl = i & 1;
        if (i + 1 < NT) { dma_k(kv, 64 * (kt - 1), lds0, sl ^ 1, wid, lane); dma_v(kv, 64 * (kt - 1), lds0, sl ^ 1, wid, lane); WAIT_BAR(2); }
        else WAIT_BAR(0);
        if (64 * kt <= T0 + 30 && !mydone) {
            f32x16 p0, p1; qkt(p0, p1, shm3 + L_K + sl * SLOTB, qr, r32, hi);
            if (kt >= 4 * qb) sb_tile<true>(p0, p1, 64 * kt, t, C, hi); else sb_tile<false>(p0, p1, 64 * kt, t, C, hi);
            bf16x8 a0, a1, a2, a3; pack_p(p0, p1, a0, a1, a2, a3);
            pv(o, vb0 + sl * SLOTB, a0, a1, a2, a3);
            mydone = __all(C == 0.f) != 0;
        }
        if (lane == 0) flag[wid] = mydone ? 1u : 0u;
        WAIT_BAR_L();
        unsigned all = 1u;
#pragma unroll
        for (int w = 0; w < 8; ++w) all &= flag[w];
        if (__builtin_amdgcn_readfirstlane(all) != 0u) break;
        asm volatile("s_waitcnt lgkmcnt(0)" ::: "memory");
    }
    WAIT_BAR(0);
    store_o(o, 1.0f, false, O + (row0 + T0) * D + h * 64, D, shm, wid, lane, r32, hi);
}
__device__ __forceinline__ void sb_phase(Frame& F) {
    for (int k = 0; k < 6; ++k) {
        const int p = 3 * F.c + (k >> 1); if (p >= BATCH * NHS * 4) break;
        const int bh = p >> 2, s = p & 3, qb = (k & 1) ? 7 - s : s;
        sb_unit(F, bh / NHS, bh % NHS, qb);
    }
}
#undef SBAR
}

__global__ void __launch_bounds__(NWAVES * 64, 2) fwd_kernel(Args args) {
    extern __shared__ __attribute__((aligned(16))) unsigned char lds[];
    Frame F;
    F.lds = (LAS unsigned char*)lds; F.MISC = (volatile LAS unsigned*)(F.lds + MISC_OFF);
    F.tid = threadIdx.x; F.lane = F.tid & 63; F.wave = __builtin_amdgcn_readfirstlane(F.tid >> 6);
    F.G = gridDim.x; F.c = blockIdx.x; F.ws = args.ws; F.out = args.out; F.ctl = (gu32*)(args.ws + WS_CTL);
    for (int u = F.tid; u < (LDS_BYTES - LDSCTL_OFF) / 4; u += NWAVES * 64) ((LAS unsigned*)(F.lds + LDSCTL_OFF))[u] = 0u;
    __syncthreads();
    XcdBarrier bar; bar.bar = (unsigned*)(F.ctl + CW_BAR) + args.li * XCD_BAR_WORDS; bar.x = 0; bar.st = nullptr;
    if (!MK_PER_PHASE) bar = xcd_barrier_post((unsigned*)(F.ctl + CW_BAR) + args.li * XCD_BAR_WORDS, F.MISC + 8);
    const int lo = args.ph_lo, hi = args.ph_hi;
#define IN(k) (lo <= (k) && (k) < hi)
#define SEAM(k) do { if (IN(k) && IN((k) + 1)) xcd_barrier(bar); } while (0)
    unsigned char* const ws = args.ws;
    LAS unsigned char* const ring = F.lds + RING_OFF;

    if (IN(0)) { refresh_ids(F);
#if MEMKV_EARLY && !MK_PER_PHASE && !PROJ0_I8
        p0_prologue(args, F, 1, F.c * NWAVES + F.wave, F.G * NWAVES);
        xcd_barrier(bar);
        if (F.c < 64) {
            pg8::Gemm g{(const bf16*)(ws + WS_XN), (const bf16*)(ws + WS_W0IN), 0, 0, D}; pg8::MemOrder S{F.c};
            pg8::EpiProj0 E{(bf16*)(ws + WS_PROJ), (bf16*)(ws + WS_MEMKV), (const float*)(ws + WS_ROPE), (const float*)(ws + WS_TAB + TAB_ROWSC0), (const float*)(ws + WS_TAB + TAB_CS0)};
            pg8::gemm_phase<pg8::EpiProj0, pg8::MemOrder, true, true, 0>(ring, g, S, E, F.wave); }
        else p0_prologue(args, F, 2, (F.c - 64) * NWAVES + F.wave, (F.G - 64) * NWAVES);
#else
        p0_prologue(args, F, 0, F.c * NWAVES + F.wave, F.G * NWAVES);
#endif
        SEAM(0); }
    if (IN(1)) {
#if MEMKV_EARLY && !MK_PER_PHASE && !PROJ0_I8
        pg8::Gemm g{(const bf16*)(ws + WS_XN), (const bf16*)(ws + WS_W0IN), 0, 0, D}; pg8::StaticOrder S; S.init(M, N0, F.G, F.c);
        pg8::EpiProj0 E{(bf16*)(ws + WS_PROJ), (bf16*)(ws + WS_MEMKV), (const float*)(ws + WS_ROPE), (const float*)(ws + WS_TAB + TAB_ROWSC0), (const float*)(ws + WS_TAB + TAB_CS0)};
        pg8::gemm_phase<pg8::EpiProj0, pg8::StaticOrder, true, true, 0>(ring, g, S, E, F.wave);
#else
        pg8::Gemm g{(const bf16*)(ws + WS_XN), (const bf16*)(ws + WS_W0IN), 0, 0, PROJ0_I8 ? D / 2 : D}; pg8::Proj0Order S; S.init(F.G, F.c);
        pg8::EpiProj0 E{(bf16*)(ws + WS_PROJ), (bf16*)(ws + WS_MEMKV), (const float*)(ws + WS_ROPE), (const float*)(ws + WS_TAB + TAB_ROWSC0), (const float*)(ws + WS_TAB + TAB_CS0)};
        pg8::gemm_phase<pg8::EpiProj0, pg8::Proj0Order, true, true, PROJ0_I8 ? 2 : 0>(ring, g, S, E, F.wave);
#endif
        SEAM(1);
    }
    if (IN(2)) { refresh_ids(F);
        att::swa_phase(F, (const float*)args.in[7]);
        att::cross_phase(F, (const bf16*)(ws + WS_PROJ), N0, P0_QC, (const bf16*)(ws + WS_MEMKV));
        SEAM(2); }
    if (IN(3)) {
        pg8::Gemm g{(const bf16*)(ws + WS_ATT), (const bf16*)(ws + WS_W0OUT), 0, 0, D}; pg8::StaticOrder S; S.init(M, D, F.G, F.c);
        pg8::EpiPlain E{(bf16*)(ws + WS_MIX), D, 1.0f};
        pg8::gemm_phase<pg8::EpiPlain, pg8::StaticOrder, true, true>(ring, g, S, E, F.wave);
        SEAM(3);
    }
    if (IN(4)) { refresh_ids(F);
#if FFN0_MODE == 2
        {
            LAS float* scr = (LAS float*)(F.lds + RING_OFF + F.wave * 16384); const int gw = F.c * NWAVES + F.wave, NGW = F.G * NWAVES;
            const unsigned* cmax = (const unsigned*)(F.ctl + CW_CMAX);
            for (int it = gw; it < 8 * 224; it += NGW) transpose_item<2>(MapGUq{(const float*)args.in[11], (const float*)args.in[12], cmax}, D, ws + WS_W0GU, 224, scr, it, F.lane);
            float* csg = (float*)(ws + WS_TAB + TAB_CSG);
            for (int i = F.c * (NWAVES * 64) + F.tid; i < 2 * FF; i += F.G * NWAVES * 64) { const float am = __uint_as_float(__hip_atomic_load(cmax + i, RLX_AGENT)); (i < FF ? csg : (float*)(ws + WS_TAB + TAB_CSU) - FF)[i] = am * (1.0f / 127.0f); }
            __syncthreads(); }
#endif
        phase_norm_res<FFN0_MODE, false>(F, (const bf16*)(ws + WS_MIX), (const void*)args.in[0], (const float*)args.in[9], (const float*)args.in[10], (bf16*)(ws + WS_XN), (float*)(ws + WS_TAB + TAB_ROWSC)); SEAM(4); }
    if (IN(5)) {
#if FFN0_MODE == 2
        pg8::Gemm g{(const bf16*)(ws + WS_XN), (const bf16*)(ws + WS_W0GU), 0, 0, D / 2}; pg8::StaticOrder S; S.init(M, 2 * FF, F.G, F.c);
        pg8::EpiSwigluI8 E{(bf16*)(ws + WS_HID), (const float*)(ws + WS_TAB + TAB_ROWSC), (const float*)(ws + WS_TAB + TAB_CSG), (const float*)(ws + WS_TAB + TAB_CSU), H_SCALE};
        pg8::gemm_phase<pg8::EpiSwigluI8, pg8::StaticOrder, true, true, 2>(ring, g, S, E, F.wave);
#else
        pg8::Gemm g{(const bf16*)(ws + WS_XN), (const bf16*)(ws + WS_W0GU), 0, 0, D}; pg8::StaticOrder S; S.init(M, 2 * FF, F.G, F.c);
        pg8::EpiSwiglu E{(bf16*)(ws + WS_HID)};
        pg8::gemm_phase<pg8::EpiSwiglu, pg8::StaticOrder, true, true>(ring, g, S, E, F.wave);
#endif
        SEAM(5);
    }
    if (IN(6)) {
#if DOWN0_FP8 && FFN0_MODE == 2
        pg8::Gemm g{(const bf16*)(ws + WS_HID), (const bf16*)(ws + WS_W0DOWN), 0, 0, FF / 2}; pg8::StaticOrder S; S.init(M, D, F.G, F.c);
        pg8::EpiPlain E{(bf16*)(ws + WS_MIX), D, 1.0f / (H_SCALE * WDN_SCALE)};
        pg8::gemm_phase<pg8::EpiPlain, pg8::StaticOrder, true, true, 1>(ring, g, S, E, F.wave);
#else
        pg8::Gemm g{(const bf16*)(ws + WS_HID), (const bf16*)(ws + WS_W0DOWN), 0, 0, FF}; pg8::StaticOrder S; S.init(M, D, F.G, F.c);
        pg8::EpiPlain E{(bf16*)(ws + WS_MIX), D, 1.0f};
        pg8::gemm_phase<pg8::EpiPlain, pg8::StaticOrder, true, true>(ring, g, S, E, F.wave);
#endif
        SEAM(6);
    }
    if (IN(7)) { refresh_ids(F);
#if PROJ1_I8
        {
            LAS float* scr = (LAS float*)(F.lds + RING_OFF + F.wave * 16384); const int gw = F.c * NWAVES + F.wave, NGW = F.G * NWAVES;
            const unsigned* cmax = (const unsigned*)(F.ctl + CW_CMAX1);
            for (int it = gw; it < 8 * 80; it += NGW) transpose_item<2>(MapIdentQ{(const float*)args.in[17], N1, cmax}, D, ws + WS_W1IN, 80, scr, it, F.lane);
            float* cs1 = (float*)(ws + WS_TAB + TAB_CS1);
            for (int i = F.c * (NWAVES * 64) + F.tid; i < N1; i += F.G * NWAVES * 64) { const float am = __uint_as_float(__hip_atomic_load(cmax + i, RLX_AGENT)); cs1[i] = am * (1.0f / 127.0f) * ((i < 768 || i >= 2304) ? QSCALE : 1.0f); }
            __syncthreads(); }
        phase_norm_res<2, true>(F, (const bf16*)(ws + WS_MIX), (const void*)(ws + WS_RES), (const float*)args.in[14], (const float*)args.in[15], (bf16*)(ws + WS_XN), (float*)(ws + WS_TAB + TAB_ROWSC)); SEAM(7); }
#else
        phase_norm_res<0, true>(F, (const bf16*)(ws + WS_MIX), (const void*)(ws + WS_RES), (const float*)args.in[14], (const float*)args.in[15], (bf16*)(ws + WS_XN), nullptr); SEAM(7); }
#endif
    if (IN(8)) {
#if PROJ1_I8
        pg8::Gemm g{(const bf16*)(ws + WS_XN), (const bf16*)(ws + WS_W1IN), 0, 0, D / 2}; pg8::StaticOrder S; S.init(M, N1, F.G, F.c);
        pg8::EpiPlainI8 E{(bf16*)(ws + WS_PROJ), N1, (const float*)(ws + WS_TAB + TAB_ROWSC), (const float*)(ws + WS_TAB + TAB_CS1)};
        pg8::gemm_phase<pg8::EpiPlainI8, pg8::StaticOrder, true, true, 2>(ring, g, S, E, F.wave);
#else
        pg8::Gemm g{(const bf16*)(ws + WS_XN), (const bf16*)(ws + WS_W1IN), 0, 0, D}; pg8::StaticOrder S; S.init(M, N1, F.G, F.c);
        pg8::EpiPlain E{(bf16*)(ws + WS_PROJ), N1, 1.0f};
        pg8::gemm_phase<pg8::EpiPlain, pg8::StaticOrder, true, true>(ring, g, S, E, F.wave);
#endif
        SEAM(8);
    }
    if (IN(9)) { refresh_ids(F);
        att::sb_phase(F);
        att::cross_phase(F, (const bf16*)(ws + WS_PROJ), N1, P1_QC, (const bf16*)(ws + WS_MEMKV) + (size_t)MEMR * 512);
        SEAM(9); }
    if (IN(10)) {
        pg8::Gemm g{(const bf16*)(ws + WS_ATT), (const bf16*)(ws + WS_W1OUT), 0, 0, D}; pg8::StaticOrder S; S.init(M, D, F.G, F.c);
        pg8::EpiPlain E{(bf16*)(ws + WS_MIX), D, 1.0f};
        pg8::gemm_phase<pg8::EpiPlain, pg8::StaticOrder, true, true>(ring, g, S, E, F.wave);
        SEAM(10);
    }
    if (IN(11)) { refresh_ids(F); phase_route(args, F); SEAM(11); }
    if (IN(12)) { refresh_ids(F); phase_permute(args, F); SEAM(12); }
#if MOE_FP8
    if (IN(13)) { refresh_ids(F); const int T = build_expert_table(F);
        pg8::Gemm g{(const bf16*)(ws + WS_XS), (const bf16*)(ws + WS_W1GU), 0, 0, D / 2}; pg8::MoeOrder<false> S; S.init(T, 2 * FF / 256, 0, (const LAS unsigned char*)(F.lds + ETAB_OFF), F.G, F.c);
        pg8::EpiSwiglu8 E{ws + WS_HID8, 1.0f / (XS_SCALE * WGU_SCALE), H_SCALE};
        pg8::gemm_phase<pg8::EpiSwiglu8, pg8::MoeOrder<false>, true, true, 1>(ring, g, S, E, F.wave);
        SEAM(13); }
    if (IN(14)) { refresh_ids(F); const int T = build_expert_table(F);
        pg8::Gemm g{(const bf16*)(ws + WS_HID8), (const bf16*)(ws + WS_W1DOWN), 0, 0, FF / 2}; pg8::MoeOrder<true> S; S.init(T < TAIL_TILE0 ? T : TAIL_TILE0, D / 256, 0, (const LAS unsigned char*)(F.lds + ETAB_OFF), F.G, F.c);
        pg8::EpiMoeDown E{(bf16*)(ws + WS_YS), (const float*)(ws + WS_TAB + TAB_SLOTW), 1.0f / (H_SCALE * WDN_SCALE)};
        pg8::gemm_phase<pg8::EpiMoeDown, pg8::MoeOrder<true>, true, true, 1>(ring, g, S, E, F.wave);
        SEAM(14); }
    if (IN(15)) { refresh_ids(F); const int T = build_expert_table(F); const int ntail = T > TAIL_TILE0 ? T - TAIL_TILE0 : 0, nu = ntail * (D / 256);
        bool poison = false;
        if (!MK_PER_PHASE) for (int li = 0; li <= args.li; ++li) poison |= __hip_atomic_load((unsigned*)(F.ctl + CW_BAR) + li * XCD_BAR_WORDS + XB_TMO, RLX_AGENT) != 0u;
        if (F.c < nu) {
            pg8::Gemm g{(const bf16*)(ws + WS_HID8), (const bf16*)(ws + WS_W1DOWN), 0, 0, FF / 2}; pg8::MoeOrder<true> S; S.init(ntail, D / 256, TAIL_TILE0, (const LAS unsigned char*)(F.lds + ETAB_OFF), F.G, F.c, TAIL_TILE0);
            pg8::EpiMoeDown E{(bf16*)(ws + WS_YS), (const float*)(ws + WS_TAB + TAB_SLOTW), 1.0f / (H_SCALE * WDN_SCALE)};
            pg8::gemm_phase<pg8::EpiMoeDown, pg8::MoeOrder<true>, true, true, 1>(ring, g, S, E, F.wave); }
        else phase_final(args, F, poison, 0, nu);
        SEAM(15); }
#else
#define MOE_CHUNK(ck) \
    if (IN(13 + 2 * (ck))) { refresh_ids(F); const int T = build_expert_table(F); const int t0 = (ck) * CHT; int nM = T - t0; nM = nM < 0 ? 0 : (nM > CHT ? CHT : nM); \
        pg8::Gemm g{(const bf16*)(ws + WS_XS), (const bf16*)(ws + WS_W1GU), 0, 0, D}; pg8::MoeOrder<false> S; S.init(nM, 2 * FF / 256, t0, (const LAS unsigned char*)(F.lds + ETAB_OFF), F.G, F.c); \
        pg8::EpiSwiglu E{(bf16*)(ws + WS_HID)}; \
        pg8::gemm_phase<pg8::EpiSwiglu, pg8::MoeOrder<false>, true, true>(ring, g, S, E, F.wave); \
        SEAM(13 + 2 * (ck)); } \
    if (IN(14 + 2 * (ck))) { refresh_ids(F); const int T = build_expert_table(F); const int t0 = (ck) * CHT; int nM = T - t0; nM = nM < 0 ? 0 : (nM > CHT ? CHT : nM); \
        pg8::Gemm g{(const bf16*)(ws + WS_HID), (const bf16*)(ws + WS_W1DOWN), 0, 0, FF}; pg8::MoeOrder<true> S; S.init(nM, D / 256, t0, (const LAS unsigned char*)(F.lds + ETAB_OFF), F.G, F.c); \
        pg8::EpiMoeDown E{(bf16*)(ws + WS_YS), (const float*)(ws + WS_TAB + TAB_SLOTW), 1.0f}; \
        pg8::gemm_phase<pg8::EpiMoeDown, pg8::MoeOrder<true>, true, true>(ring, g, S, E, F.wave); \
        SEAM(14 + 2 * (ck)); }
    MOE_CHUNK(0)
    MOE_CHUNK(1)
    MOE_CHUNK(2)
#undef MOE_CHUNK
#endif
    if (IN(PH_FINAL)) { refresh_ids(F);
        bool poison = false;
        if (!MK_PER_PHASE) for (int li = 0; li <= args.li; ++li) poison |= __hip_atomic_load((unsigned*)(F.ctl + CW_BAR) + li * XCD_BAR_WORDS + XB_TMO, RLX_AGENT) != 0u;
        phase_final(args, F, poison, 1, 0);
    }
#undef IN
#undef SEAM
#undef MOE_CHUNK
}

extern "C" void kernel_launch(void* const* d_in, const int* in_sizes, int n_in, void* d_out, int out_size, void* d_ws, size_t ws_size, hipStream_t stream) {
    static int grid = 0;
    if (grid == 0) {
        if (n_in != 27 || in_sizes[0] != M * D || out_size != M * D || ws_size < WS_END) { fprintf(stderr, "kernel_launch: shape / workspace mismatch (n_in %d, ws %zu); nothing launched\n", n_in, ws_size); grid = -1; return; }
        int dev = 0, cus = 0;
        if (hipGetDevice(&dev) != hipSuccess || hipDeviceGetAttribute(&cus, hipDeviceAttributeMultiprocessorCount, dev) != hipSuccess) { grid = -1; return; }
        if (hipFuncSetAttribute((const void*)fwd_kernel, hipFuncAttributeMaxDynamicSharedMemorySize, LDS_BYTES) != hipSuccess) { grid = -1; return; }
        (void)hipGetLastError();
        if (cus != 256) { fprintf(stderr, "kernel_launch: built for 256 CUs, found %d; nothing launched\n", cus); grid = -1; return; }
        grid = 256;
    }
    if (grid < 0) return;
    if (hipMemsetAsync((char*)d_ws + WS_CTL, 0, CTL_ZERO_BYTES, stream) != hipSuccess) return;
    Args a{};
    for (int i = 0; i < 27; ++i) a.in[i] = d_in[i];
    a.out = (float*)d_out; a.ws = (unsigned char*)d_ws;
#if MK_PER_PHASE
    for (int p = 0; p < NPHASE; ++p) { a.ph_lo = p; a.ph_hi = p + 1; a.li = 0; hipLaunchKernelGGL(fwd_kernel, dim3(grid), dim3(NWAVES * 64), LDS_BYTES, stream, a); }
#elif defined(PROBE_SEGS)
    const int segs[][2] = {PROBE_SEGS};
    for (int i = 0; i < (int)(sizeof(segs) / sizeof(segs[0])); ++i) { a.ph_lo = segs[i][0]; a.ph_hi = segs[i][1]; a.li = i; hipLaunchKernelGGL(fwd_kernel, dim3(grid), dim3(NWAVES * 64), LDS_BYTES, stream, a); }
#else
    a.ph_lo = 0; a.ph_hi = NPHASE; a.li = 0;
    hipLaunchKernelGGL(fwd_kernel, dim3(grid), dim3(NWAVES * 64), LDS_BYTES, stream, a);
#endif
}
```

```cpp
#define DOWN0_FP8 1
#include <hip/hip_runtime.h>
#include <cstdio>
#include <cstdint>

#ifndef MOE_FP8
#define MOE_FP8 1
#endif
#ifndef FFN0_MODE
#define FFN0_MODE 2
#endif
#ifndef DOWN0_FP8
#define DOWN0_FP8 0
#endif
#ifndef PROJ1_I8
#define PROJ1_I8 1
#endif
#ifndef PROJ0_I8
#define PROJ0_I8 0
#endif
#ifndef MEMKV_EARLY
#define MEMKV_EARLY 1
#endif
#ifndef MK_PER_PHASE
#define MK_PER_PHASE 0
#endif

namespace pg8 {
#define PG8_LAS __attribute__((address_space(3)))
typedef unsigned short bf16_t;
typedef short bf16x8 __attribute__((ext_vector_type(8)));
typedef float f32x4 __attribute__((ext_vector_type(4)));
typedef unsigned u32x4 __attribute__((ext_vector_type(4)));
constexpr int BM = 256, BK = 64, HALF = 128, HTB = HALF * BK * 2  , STAGE_BYTES = 8 * HTB, NXCD = 8, WGM = 8;

__host__ __device__ __forceinline__ int lds_byte(int r, int c) { const int st = (r >> 4) * 2 + (c >> 5), rr = r & 15, cc = c & 31, ob = rr * 64 + cc * 2; return st * 1024 + (ob ^ (((ob >> 9) & 1) << 5)); }
__host__ __device__ __forceinline__ void stage_rc(int b, int& R, int& C) { const int st = b / 1024, sb = b % 1024, swz = sb ^ (((sb >> 9) & 1) << 5); R = (st >> 1) * 16 + swz / 64; C = (st & 1) * 32 + (swz % 64) / 2; }
__host__ __device__ __forceinline__ int perm32(int rho) { const int n = rho >> 4, i = rho & 15; return 8 * (i >> 2) + 4 * n + (i & 3); }

struct Unit { int pm, pn, om, on; };
struct Gemm { const bf16_t* A; const bf16_t* Bt; int M, N, K; };

struct StaticOrder {
    int nM, nN, nwg, G, c;
    __host__ __device__ void init(int M, int N, int G_, int c_) { nM = M / BM; nN = N / BM; nwg = nM * nN; G = G_; c = c_; }
    __host__ __device__ bool tile(int i, int& tm, int& tn) const {
        const long L = (long)i * G + c; if (L >= nwg) return false;
        int wgid = (int)L; { const int q = nwg / NXCD, r = nwg % NXCD, xcd = wgid % NXCD, off = wgid / NXCD; wgid = (xcd < r ? xcd * (q + 1) : r * (q + 1) + (xcd - r) * q) + off; }
        const int nig = WGM * nN, gid = wgid / nig, fm = gid * WGM, gsz = (nM - fm) < WGM ? (nM - fm) : WGM;
        tm = fm + ((wgid % nig) % gsz); tn = (wgid % nig) / gsz; return true;
    }
    __host__ __device__ bool next(int i, Unit& u) const { int tm, tn; if (!tile(i, tm, tn)) return false; u.pm = tm; u.pn = tn; u.om = tm; u.on = tn; return true; }
    __device__ __forceinline__ void a_ready(const Unit&) const {}
    __device__ __forceinline__ void done(const Unit&) const {}
};
struct Proj0Order {
    StaticOrder so; int nmain;
    __device__ void init(int G_, int c_) { so.init(32768, 1536, G_, c_); nmain = so.nwg; }
    __device__ bool next(int i, Unit& u) const {
        const long L = (long)i * so.G + so.c;
        if (L < nmain) return so.next(i, u);
        const int x = (int)(L - nmain); if (x >= 64) return false;
        const int w = x >> 5, y = x & 31;
        u.pm = 128 + 16 * w + (y >> 1); u.pn = 6 + 2 * w + (y & 1); u.om = u.pm; u.on = u.pn; return true;
    }
    __device__ __forceinline__ void a_ready(const Unit&) const {}
    __device__ __forceinline__ void done(const Unit&) const {}
};
struct MemOrder {
    int c;
    __device__ bool next(int i, Unit& u) const { if (i != 0 || c >= 64) return false; const int w = c >> 5, y = c & 31; u.pm = 128 + 16 * w + (y >> 1); u.pn = 6 + 2 * w + (y & 1); u.om = u.pm; u.on = u.pn; return true; }
    __device__ __forceinline__ void a_ready(const Unit&) const {}
    __device__ __forceinline__ void done(const Unit&) const {}
};
template <bool A_LOCAL> struct MoeOrder {
    StaticOrder so; int t0, a_add; const PG8_LAS unsigned char* tab;
    __device__ void init(int nM, int nN, int t0_, const PG8_LAS unsigned char* tab_, int G_, int c_, int a_add_ = 0) { so.init(nM * BM, nN * BM, G_, c_); t0 = t0_; tab = tab_; a_add = a_add_; }
    __device__ bool next(int i, Unit& u) const {
        int tm, tn; if (so.nwg <= 0 || !so.tile(i, tm, tn)) return false;
        const int gt = t0 + tm, e = (int)tab[gt];
        u.pm = (A_LOCAL ? tm : gt) + a_add; u.pn = e * so.nN + tn; u.om = A_LOCAL ? gt : tm; u.on = tn; return true;
    }
    __device__ __forceinline__ void a_ready(const Unit&) const {}
    __device__ __forceinline__ void done(const Unit&) const {}
};

__device__ __forceinline__ unsigned cvt_pk_bf16(float lo, float hi) { unsigned r; asm volatile("v_cvt_pk_bf16_f32 %0, %1, %2" : "=v"(r) : "v"(lo), "v"(hi)); return r; }
__device__ __forceinline__ u32x4 pack8(const f32x4 a, const f32x4 b) { u32x4 w; w.x = cvt_pk_bf16(a[0], a[1]); w.y = cvt_pk_bf16(a[2], a[3]); w.z = cvt_pk_bf16(b[0], b[1]); w.w = cvt_pk_bf16(b[2], b[3]); return w; }

struct EpiPlain {
    static constexpr bool PERM = true, AFTER_DRAIN = false;
    bf16_t* O; int ldc; float ascale;
    __device__ __forceinline__ void operator()(const f32x4 (&acc)[2][2][4][2], const Unit& u, int wr, int wc, int fr, int fq) const {
        const int row0 = u.om * BM + wr * 64 + fr, col0 = u.on * BM + wc * 32 + 8 * fq;
#pragma unroll
        for (int ai = 0; ai < 2; ++ai)
#pragma unroll
            for (int m = 0; m < 4; ++m) { bf16_t* rowp = O + (size_t)(row0 + ai * HALF + m * 16) * ldc + col0;
#pragma unroll
                for (int bj = 0; bj < 2; ++bj) *(u32x4*)(rowp + bj * HALF) = pack8(acc[ai][bj][m][0] * ascale, acc[ai][bj][m][1] * ascale); }
    }
};
struct EpiProj0 {
    static constexpr bool PERM = true, AFTER_DRAIN = false;
    bf16_t* P; bf16_t* KV; const float* rope;
    const float* rowscale; const float* colscale;
    __device__ __forceinline__ void operator()(const f32x4 (&acc)[2][2][4][2], const Unit& u, int wr, int wc, int fr, int fq) const {
        bf16_t* base; int ldc, rowt, colt; bool do_rope;
        if (u.pm < 128) { base = P; ldc = 1536; rowt = u.pm; colt = u.pn; do_rope = u.pn < 4; }
        else { const int w = (u.pm >= 144) ? 1 : 0; base = KV + (size_t)w * 4096 * 512; ldc = 512; rowt = u.pm - 128 - 16 * w; colt = u.pn - 6 - 2 * w; do_rope = false; }
        const int row0 = rowt * BM + wr * 64 + fr, col0 = colt * BM + wc * 32 + 8 * fq, dl = 16 * (wc & 1) + 4 * fq;
        f32x4 csc[2][2];
        if (PROJ0_I8) {
#pragma unroll
            for (int bj = 0; bj < 2; ++bj) { csc[bj][0] = *(const f32x4*)(colscale + u.pn * BM + wc * 32 + 8 * fq + bj * HALF); csc[bj][1] = *(const f32x4*)(colscale + u.pn * BM + wc * 32 + 8 * fq + bj * HALF + 4); } }
#pragma unroll
        for (int ai = 0; ai < 2; ++ai)
#pragma unroll
            for (int m = 0; m < 4; ++m) { const int r = row0 + ai * HALF + m * 16; bf16_t* rowp = base + (size_t)r * ldc + col0;
                float rsc = 1.f; if (PROJ0_I8) rsc = rowscale[u.pm * BM + wr * 64 + fr + ai * HALF + m * 16];
                f32x4 cs = (f32x4){1.f, 1.f, 1.f, 1.f}, sn = (f32x4){0.f, 0.f, 0.f, 0.f};
                if (do_rope) { cs = *(const f32x4*)(rope + (size_t)r * 64 + dl); sn = *(const f32x4*)(rope + (size_t)r * 64 + 32 + dl); }
#pragma unroll
                for (int bj = 0; bj < 2; ++bj) { f32x4 v0 = acc[ai][bj][m][0], v1 = acc[ai][bj][m][1];
                    if (PROJ0_I8) { typedef int i32x4 __attribute__((ext_vector_type(4))); const i32x4 a0 = __builtin_bit_cast(i32x4, v0), a1 = __builtin_bit_cast(i32x4, v1);
                        v0 = (f32x4){(float)a0[0], (float)a0[1], (float)a0[2], (float)a0[3]} * (csc[bj][0] * rsc); v1 = (f32x4){(float)a1[0], (float)a1[1], (float)a1[2], (float)a1[3]} * (csc[bj][1] * rsc); }
                    const f32x4 o0 = v0 * cs - v1 * sn, o1 = v1 * cs + v0 * sn;
                    *(u32x4*)(rowp + bj * HALF) = pack8(o0, o1); } }
    }
};
__device__ __forceinline__ float silu_mul(float g, float u) { return g * __builtin_amdgcn_rcpf(1.0f + __builtin_amdgcn_exp2f(-1.4426950408889634f * g)) * u; }
typedef float f32x2 __attribute__((ext_vector_type(2)));
__device__ __forceinline__ f32x2 sig_mul2(f32x2 tg, f32x2 pu) { f32x2 e; e.x = __builtin_amdgcn_exp2f(tg.x); e.y = __builtin_amdgcn_exp2f(tg.y); const f32x2 d = e + 1.0f; f32x2 r; r.x = __builtin_amdgcn_rcpf(d.x); r.y = __builtin_amdgcn_rcpf(d.y); return pu * r; }
struct EpiSwiglu {
    static constexpr bool PERM = true, AFTER_DRAIN = false;
    bf16_t* H;
    __device__ __forceinline__ void operator()(const f32x4 (&acc)[2][2][4][2], const Unit& u, int wr, int wc, int fr, int fq) const {
        const int row0 = u.om * BM + wr * 64 + fr, col0 = u.on * HALF + wc * 32 + 8 * fq;
#pragma unroll
        for (int ai = 0; ai < 2; ++ai)
#pragma unroll
            for (int m = 0; m < 4; ++m) { bf16_t* rowp = H + (size_t)(row0 + ai * HALF + m * 16) * 3584 + col0;
                f32x4 h0, h1;
#pragma unroll
                for (int j = 0; j < 4; ++j) { h0[j] = silu_mul(acc[ai][0][m][0][j], acc[ai][1][m][0][j]); h1[j] = silu_mul(acc[ai][0][m][1][j], acc[ai][1][m][1][j]); }
                *(u32x4*)rowp = pack8(h0, h1); }
    }
};
__device__ __forceinline__ unsigned pk4_fp8(float a, float b, float c, float d) {
    a = __builtin_amdgcn_fmed3f(a, -448.f, 448.f); b = __builtin_amdgcn_fmed3f(b, -448.f, 448.f); c = __builtin_amdgcn_fmed3f(c, -448.f, 448.f); d = __builtin_amdgcn_fmed3f(d, -448.f, 448.f);
    int w = 0; w = __builtin_amdgcn_cvt_pk_fp8_f32(a, b, w, false); w = __builtin_amdgcn_cvt_pk_fp8_f32(c, d, w, true); return (unsigned)w; }
struct EpiSwiglu8 {
    static constexpr bool PERM = true, AFTER_DRAIN = false;
    unsigned char* H; float ascale, hscale;
    __device__ __forceinline__ void operator()(const f32x4 (&acc)[2][2][4][2], const Unit& u, int wr, int wc, int fr, int fq) const {
        typedef unsigned u32x2 __attribute__((ext_vector_type(2)));
        const int row0 = u.om * BM + wr * 64 + fr, col0 = u.on * HALF + wc * 32 + 8 * fq;
#pragma unroll
        for (int ai = 0; ai < 2; ++ai)
#pragma unroll
            for (int m = 0; m < 4; ++m) { unsigned char* rowp = H + (size_t)(row0 + ai * HALF + m * 16) * 3584 + col0;
                const float c1 = -1.4426950408889634f * ascale, c2 = ascale * ascale * hscale;
                const f32x4 g0 = acc[ai][0][m][0], g1 = acc[ai][0][m][1], u0 = acc[ai][1][m][0], u1 = acc[ai][1][m][1];
                const f32x2 a = sig_mul2((f32x2){g0[0], g0[1]} * c1, (f32x2){g0[0], g0[1]} * (f32x2){u0[0], u0[1]} * c2), b = sig_mul2((f32x2){g0[2], g0[3]} * c1, (f32x2){g0[2], g0[3]} * (f32x2){u0[2], u0[3]} * c2);
                const f32x2 c = sig_mul2((f32x2){g1[0], g1[1]} * c1, (f32x2){g1[0], g1[1]} * (f32x2){u1[0], u1[1]} * c2), d = sig_mul2((f32x2){g1[2], g1[3]} * c1, (f32x2){g1[2], g1[3]} * (f32x2){u1[2], u1[3]} * c2);
                const f32x4 h0 = (f32x4){a.x, a.y, b.x, b.y}, h1 = (f32x4){c.x, c.y, d.x, d.y};
                u32x2 w; w.x = pk4_fp8(h0[0], h0[1], h0[2], h0[3]); w.y = pk4_fp8(h1[0], h1[1], h1[2], h1[3]); *(u32x2*)rowp = w; }
    }
};
struct EpiSwigluI8 {
    static constexpr bool PERM = true, AFTER_DRAIN = false;
    bf16_t* H; const float* rowscale; const float* cs_gate; const float* cs_up; float hscale;
    __device__ __forceinline__ void operator()(const f32x4 (&acc)[2][2][4][2], const Unit& u, int wr, int wc, int fr, int fq) const {
        typedef int i32x4 __attribute__((ext_vector_type(4)));
        const int row0 = u.om * BM + wr * 64 + fr, col0 = u.on * HALF + wc * 32 + 8 * fq;
        const f32x4 g0 = *(const f32x4*)(cs_gate + col0), g1 = *(const f32x4*)(cs_gate + col0 + 4), gu0 = g0 * *(const f32x4*)(cs_up + col0), gu1 = g1 * *(const f32x4*)(cs_up + col0 + 4);
#pragma unroll
        for (int ai = 0; ai < 2; ++ai)
#pragma unroll
            for (int m = 0; m < 4; ++m) { const int r = row0 + ai * HALF + m * 16; const float rs = rowscale[r]; bf16_t* rowp = H + (size_t)r * 3584 + col0;
                const i32x4 ag0 = __builtin_bit_cast(i32x4, acc[ai][0][m][0]), ag1 = __builtin_bit_cast(i32x4, acc[ai][0][m][1]), au0 = __builtin_bit_cast(i32x4, acc[ai][1][m][0]), au1 = __builtin_bit_cast(i32x4, acc[ai][1][m][1]);
                const float rs1 = -1.4426950408889634f * rs, rs2 = rs * rs;
                f32x4 h0, h1;
#pragma unroll
                for (int j = 0; j < 4; j += 2) {
                    const f32x2 a = sig_mul2((f32x2){(float)ag0[j], (float)ag0[j + 1]} * ((f32x2){g0[j], g0[j + 1]} * rs1), (f32x2){(float)ag0[j], (float)ag0[j + 1]} * (f32x2){(float)au0[j], (float)au0[j + 1]} * ((f32x2){gu0[j], gu0[j + 1]} * rs2));
                    const f32x2 b = sig_mul2((f32x2){(float)ag1[j], (float)ag1[j + 1]} * ((f32x2){g1[j], g1[j + 1]} * rs1), (f32x2){(float)ag1[j], (float)ag1[j + 1]} * (f32x2){(float)au1[j], (float)au1[j + 1]} * ((f32x2){gu1[j], gu1[j + 1]} * rs2));
                    h0[j] = a.x; h0[j + 1] = a.y; h1[j] = b.x; h1[j + 1] = b.y; }
                if (DOWN0_FP8) { typedef unsigned u32x2 __attribute__((ext_vector_type(2))); u32x2 w; w.x = pk4_fp8(h0[0] * hscale, h0[1] * hscale, h0[2] * hscale, h0[3] * hscale); w.y = pk4_fp8(h1[0] * hscale, h1[1] * hscale, h1[2] * hscale, h1[3] * hscale);
                    *(u32x2*)((unsigned char*)H + (size_t)r * 3584 + col0) = w; }
                else *(u32x4*)rowp = pack8(h0, h1); }
    }
};
struct EpiPlainI8 {
    static constexpr bool PERM = true, AFTER_DRAIN = false;
    bf16_t* O; int ldc; const float* rowscale; const float* colscale;
    __device__ __forceinline__ void operator()(const f32x4 (&acc)[2][2][4][2], const Unit& u, int wr, int wc, int fr, int fq) const {
        typedef int i32x4 __attribute__((ext_vector_type(4)));
        const int row0 = u.om * BM + wr * 64 + fr, col0 = u.on * BM + wc * 32 + 8 * fq;
        f32x4 cs[2][2];
#pragma unroll
        for (int bj = 0; bj < 2; ++bj) { cs[bj][0] = *(const f32x4*)(colscale + col0 + bj * HALF); cs[bj][1] = *(const f32x4*)(colscale + col0 + bj * HALF + 4); }
#pragma unroll
        for (int ai = 0; ai < 2; ++ai)
#pragma unroll
            for (int m = 0; m < 4; ++m) { const int r = row0 + ai * HALF + m * 16; const float rs = rowscale[r]; bf16_t* rowp = O + (size_t)r * ldc + col0;
#pragma unroll
                for (int bj = 0; bj < 2; ++bj) { const i32x4 a0 = __builtin_bit_cast(i32x4, acc[ai][bj][m][0]), a1 = __builtin_bit_cast(i32x4, acc[ai][bj][m][1]);
                    const f32x4 v0 = (f32x4){(float)a0[0], (float)a0[1], (float)a0[2], (float)a0[3]} * (cs[bj][0] * rs), v1 = (f32x4){(float)a1[0], (float)a1[1], (float)a1[2], (float)a1[3]} * (cs[bj][1] * rs);
                    *(u32x4*)(rowp + bj * HALF) = pack8(v0, v1); } }
    }
};
struct EpiMoeDown {
    static constexpr bool PERM = true, AFTER_DRAIN = false;
    bf16_t* Y; const float* sw; float ascale;
    __device__ __forceinline__ void operator()(const f32x4 (&acc)[2][2][4][2], const Unit& u, int wr, int wc, int fr, int fq) const {
        const int row0 = u.om * BM + wr * 64 + fr, col0 = u.on * BM + wc * 32 + 8 * fq;
#pragma unroll
        for (int ai = 0; ai < 2; ++ai)
#pragma unroll
            for (int m = 0; m < 4; ++m) { const int r = row0 + ai * HALF + m * 16; const float s = sw[r] * ascale; bf16_t* rowp = Y + (size_t)r * 1024 + col0;
#pragma unroll
                for (int bj = 0; bj < 2; ++bj) *(u32x4*)(rowp + bj * HALF) = pack8(acc[ai][bj][m][0] * s, acc[ai][bj][m][1] * s); }
    }
};

typedef int i32x4 __attribute__((ext_vector_type(4)));
typedef int i32x8 __attribute__((ext_vector_type(8)));
__device__ __forceinline__ i32x8 cat8(bf16x8 a, bf16x8 b) { const i32x4 x = __builtin_bit_cast(i32x4, a), y = __builtin_bit_cast(i32x4, b); return __builtin_shufflevector(x, y, 0, 1, 2, 3, 4, 5, 6, 7); }
template <class Epi, class Sched, bool ALIGN_EPI = false, bool SP2 = false, int MODE = 0>
__device__ __forceinline__ void gemm_phase(PG8_LAS unsigned char* lds, const Gemm g, const Sched& S, const Epi& E, int wid) {
    constexpr bool FP8 = (MODE == 1);
    int lane; asm volatile("v_mbcnt_lo_u32_b32 %0, -1, 0\n\tv_mbcnt_hi_u32_b32 %0, -1, %0" : "=v"(lane));
    const int tid = wid * 64 + lane, wr = wid >> 2, wc = wid & 3, fr = lane & 15, fq = lane >> 4;
    const int K = g.K, nt = K / BK;
    unsigned voffA[2], voffB[2];
#pragma unroll
    for (int i = 0; i < 2; ++i) { int R, C; stage_rc(tid * 16 + i * 8192, R, C); static_assert(Epi::PERM, "weight copies are stored with each 32-row group already in perm32 order"); const int Rb = R;
        voffA[i] = (unsigned)(R * K + C) * 2u; voffB[i] = (unsigned)(Rb * K + C) * 2u; }
    const unsigned kstep = (unsigned)(BK * 2);
    const unsigned hstep = (unsigned)HALF * K * 2;
    const unsigned tstep = 2 * hstep;
    const __amdgpu_buffer_rsrc_t rs_voffA = __builtin_amdgcn_make_buffer_rsrc((void*)g.A, 0, 0x7fffffff, 0x00020000), rs_voffB = __builtin_amdgcn_make_buffer_rsrc((void*)g.Bt, 0, 0x7fffffff, 0x00020000);
    const unsigned ldsw = (unsigned)wid * 1024u;
    const int aoff = lds_byte(wr * 64 + fr, fq * 8), boff = lds_byte(wc * 32 + fr, fq * 8);
#define PG8_SA(b, h) (((b) * 2 + (h)) * HTB)
#define PG8_SB(b, h) ((4 + (b) * 2 + (h)) * HTB)
#define PG8_STAGE(bufoff, gbase, voff) do { _Pragma("unroll") for (int _i = 0; _i < 2; ++_i) \
        __builtin_amdgcn_raw_ptr_buffer_load_lds(rs_##voff, (PG8_LAS void*)(lds + (bufoff) + ldsw + _i * 8192), 16, (int)(voff)[_i], (int)(gbase), 0, 0); } while (0)
#define PG8_LDA(dst, b, h) do { if constexpr (FP8) { _Pragma("unroll") for (int m = 0; m < 4; ++m) { const i32x4 lo_ = *(const PG8_LAS i32x4*)(lds + PG8_SA(b, h) + aoff + m * 2048), hi_ = *(const PG8_LAS i32x4*)(lds + PG8_SA(b, h) + aoff + m * 2048 + 1024); dst##8[m] = __builtin_shufflevector(lo_, hi_, 0, 1, 2, 3, 4, 5, 6, 7); } } \
    else { _Pragma("unroll") for (int m = 0; m < 4; ++m) _Pragma("unroll") for (int k = 0; k < 2; ++k) dst[m][k] = *(const PG8_LAS bf16x8*)(lds + PG8_SA(b, h) + aoff + m * 2048 + k * 1024); } } while (0)
#define PG8_LDB(dst, b, h) do { if constexpr (FP8) { _Pragma("unroll") for (int n = 0; n < 2; ++n) { const i32x4 lo_ = *(const PG8_LAS i32x4*)(lds + PG8_SB(b, h) + boff + n * 2048), hi_ = *(const PG8_LAS i32x4*)(lds + PG8_SB(b, h) + boff + n * 2048 + 1024); dst##8[n] = __builtin_shufflevector(lo_, hi_, 0, 1, 2, 3, 4, 5, 6, 7); } } \
    else { _Pragma("unroll") for (int n = 0; n < 2; ++n) _Pragma("unroll") for (int k = 0; k < 2; ++k) dst[n][k] = *(const PG8_LAS bf16x8*)(lds + PG8_SB(b, h) + boff + n * 2048 + k * 1024); } } while (0)
#define PG8_MMA(ai, bj, At, Bt) do { __builtin_amdgcn_s_setprio(1); \
        if constexpr (FP8) { _Pragma("unroll") for (int m = 0; m < 4; ++m) _Pragma("unroll") for (int n = 0; n < 2; ++n) \
            acc[ai][bj][m][n] = __builtin_amdgcn_mfma_scale_f32_16x16x128_f8f6f4(Bt##8[n], At##8[m], acc[ai][bj][m][n], 0, 0, 0, 0x7f7f7f7f, 0, 0x7f7f7f7f); } \
        else if constexpr (MODE == 2) { _Pragma("unroll") for (int m = 0; m < 4; ++m) _Pragma("unroll") for (int n = 0; n < 2; ++n) _Pragma("unroll") for (int k = 0; k < 2; ++k) \
            acc[ai][bj][m][n] = __builtin_bit_cast(f32x4, __builtin_amdgcn_mfma_i32_16x16x64_i8(__builtin_bit_cast(i32x4, Bt[n][k]), __builtin_bit_cast(i32x4, At[m][k]), __builtin_bit_cast(i32x4, acc[ai][bj][m][n]), 0, 0, 0)); } \
        else { _Pragma("unroll") for (int m = 0; m < 4; ++m) _Pragma("unroll") for (int n = 0; n < 2; ++n) _Pragma("unroll") for (int k = 0; k < 2; ++k) \
            acc[ai][bj][m][n] = __builtin_amdgcn_mfma_f32_16x16x32_bf16(Bt[n][k], At[m][k], acc[ai][bj][m][n], 0, 0, 0); } \
        __builtin_amdgcn_s_setprio(0); } while (0)
#define PG8_WAIT_V(n) asm volatile("s_waitcnt vmcnt(" #n ")" ::: "memory")
#define PG8_WAIT_L(n) asm volatile("s_waitcnt lgkmcnt(" #n ")" ::: "memory")
#define PG8_BAR __builtin_amdgcn_s_barrier()
#define PG8_SCHED __builtin_amdgcn_sched_barrier(0)
    Unit cur, nxt; int ui = 0;
    if (!S.next(0, cur)) return;
    f32x4 acc[2][2][4][2];
    typedef _Float16 f16x4_ __attribute__((ext_vector_type(4)));
    f16x4_ zop; { unsigned z0_, z1_; asm volatile("v_mov_b32 %0, 0\n\tv_mov_b32 %1, 0" : "=v"(z0_), "=v"(z1_)); typedef unsigned u32x2_ __attribute__((ext_vector_type(2))); zop = __builtin_bit_cast(f16x4_, (u32x2_){z0_, z1_}); }
#define PG8_ZERO_ACC() do { _Pragma("unroll") for (int a = 0; a < 2; ++a) _Pragma("unroll") for (int b = 0; b < 2; ++b) _Pragma("unroll") for (int m = 0; m < 4; ++m) _Pragma("unroll") for (int n = 0; n < 2; ++n) \
        { asm volatile("" : "+v"(zop)); acc[a][b][m][n] = __builtin_amdgcn_mfma_f32_4x4x4f16(zop, zop, (f32x4){0.f, 0.f, 0.f, 0.f}, 0, 0, 0); } } while (0)
    PG8_ZERO_ACC();
    bf16x8 At[4][2], B0[2][2], B1[2][2]; i32x8 At8[4], B08[2], B18[2];
    unsigned cA = (unsigned)cur.pm * tstep, cB = (unsigned)cur.pn * tstep;
    S.a_ready(cur);
    if constexpr (SP2) {
        PG8_STAGE(PG8_SB(0, 0), cB, voffB); PG8_STAGE(PG8_SB(0, 1), cB + hstep, voffB); PG8_STAGE(PG8_SA(0, 0), cA, voffA); PG8_STAGE(PG8_SA(0, 1), cA + hstep, voffA);
        if (wr == 1) PG8_BAR;
        PG8_WAIT_V(2); PG8_BAR;
        PG8_STAGE(PG8_SB(1, 0), cB + kstep, voffB); PG8_STAGE(PG8_SA(1, 0), cA + kstep, voffA); PG8_STAGE(PG8_SB(1, 1), cB + hstep + kstep, voffB);
        PG8_WAIT_V(6); PG8_BAR;
    } else {
        PG8_STAGE(PG8_SB(0, 0), cB, voffB); PG8_STAGE(PG8_SA(0, 0), cA, voffA); PG8_STAGE(PG8_SB(0, 1), cB + hstep, voffB); PG8_STAGE(PG8_SA(0, 1), cA + hstep, voffA);
        if (wr == 1) PG8_BAR;
        PG8_WAIT_V(4); PG8_BAR;
        PG8_STAGE(PG8_SB(1, 0), cB + kstep, voffB); PG8_STAGE(PG8_SA(1, 0), cA + kstep, voffA); PG8_STAGE(PG8_SB(1, 1), cB + hstep + kstep, voffB);
        PG8_WAIT_V(6); PG8_BAR;
    }
    for (;;) {
        const bool has_next = S.next(ui + 1, nxt);
        const unsigned nA = has_next ? (unsigned)nxt.pm * tstep : cA, nB = has_next ? (unsigned)nxt.pn * tstep : cB;
        asm volatile(".p2align 8");
#pragma unroll 1
        for (int t = 0; t < nt; t += 2) {
            const bool last = (t == nt - 2);
            const unsigned a1 = cA + (unsigned)(t + 1) * kstep;
            const unsigned a2 = last ? nA : cA + (unsigned)(t + 2) * kstep, b2 = last ? nB : cB + (unsigned)(t + 2) * kstep;
            const unsigned a3 = a2 + kstep, b3 = b2 + kstep;
            if (last && has_next) S.a_ready(nxt);
            if constexpr (SP2) {
            PG8_LDB(B0, 0, 0); PG8_LDB(B1, 0, 1); PG8_SCHED; PG8_LDA(At, 0, 0); PG8_STAGE(PG8_SA(1, 1), a1 + hstep, voffA);
            PG8_WAIT_V(8); PG8_WAIT_L(0); PG8_BAR; PG8_MMA(0, 0, At, B0); PG8_MMA(0, 1, At, B1); PG8_BAR; PG8_SCHED;
            PG8_LDA(At, 0, 1); PG8_STAGE(PG8_SB(0, 0), b2, voffB); PG8_STAGE(PG8_SB(0, 1), b2 + hstep, voffB); PG8_STAGE(PG8_SA(0, 0), a2, voffA);
            PG8_WAIT_V(8); PG8_WAIT_L(0); PG8_BAR; PG8_MMA(1, 0, At, B0); PG8_MMA(1, 1, At, B1); PG8_BAR; PG8_SCHED;
            PG8_LDB(B0, 1, 0); PG8_LDB(B1, 1, 1); PG8_SCHED; PG8_LDA(At, 1, 0); PG8_STAGE(PG8_SA(0, 1), a2 + hstep, voffA);
            PG8_WAIT_V(8); PG8_WAIT_L(0); PG8_BAR; PG8_MMA(0, 0, At, B0); PG8_MMA(0, 1, At, B1); PG8_BAR; PG8_SCHED;
            PG8_LDA(At, 1, 1); PG8_STAGE(PG8_SB(1, 0), b3, voffB); PG8_STAGE(PG8_SB(1, 1), b3 + hstep, voffB); PG8_STAGE(PG8_SA(1, 0), a3, voffA);
            PG8_WAIT_V(8); PG8_WAIT_L(0); PG8_BAR; PG8_MMA(1, 0, At, B0); PG8_MMA(1, 1, At, B1); PG8_BAR; PG8_SCHED;
            } else {
            PG8_LDB(B0, 0, 0); PG8_SCHED; PG8_LDA(At, 0, 0); PG8_STAGE(PG8_SA(1, 1), a1 + hstep, voffA);
            PG8_WAIT_L(8); PG8_BAR; PG8_WAIT_L(0); PG8_MMA(0, 0, At, B0); PG8_BAR; PG8_SCHED;
            PG8_LDB(B1, 0, 1); PG8_STAGE(PG8_SB(0, 0), b2, voffB);
            PG8_BAR; PG8_WAIT_L(0); PG8_MMA(0, 1, At, B1); PG8_BAR;
            PG8_LDA(At, 0, 1); PG8_STAGE(PG8_SA(0, 0), a2, voffA);
            PG8_BAR; PG8_WAIT_L(0); PG8_MMA(1, 0, At, B0); PG8_BAR; PG8_SCHED;
            PG8_STAGE(PG8_SB(0, 1), b2 + hstep, voffB);
            PG8_WAIT_V(6); PG8_BAR; PG8_MMA(1, 1, At, B1); PG8_BAR;
            PG8_LDB(B0, 1, 0); PG8_SCHED; PG8_LDA(At, 1, 0); PG8_STAGE(PG8_SA(0, 1), a2 + hstep, voffA);
            PG8_WAIT_L(8); PG8_BAR; PG8_WAIT_L(0); PG8_MMA(0, 0, At, B0); PG8_BAR; PG8_SCHED;
            PG8_LDB(B1, 1, 1); PG8_STAGE(PG8_SB(1, 0), b3, voffB);
            PG8_BAR; PG8_WAIT_L(0); PG8_MMA(0, 1, At, B1); PG8_BAR;
            PG8_LDA(At, 1, 1); PG8_STAGE(PG8_SA(1, 0), a3, voffA);
            PG8_BAR; PG8_WAIT_L(0); PG8_MMA(1, 0, At, B0); PG8_BAR; PG8_SCHED;
            PG8_STAGE(PG8_SB(1, 1), b3 + hstep, voffB);
            PG8_WAIT_V(6); PG8_BAR; PG8_MMA(1, 1, At, B1); PG8_BAR;
            }
        }
        if constexpr (ALIGN_EPI) { if (wr == 0) PG8_BAR; }
        if constexpr (!Epi::AFTER_DRAIN) { E(acc, cur, wr, wc, fr, fq); S.done(cur); }
        if (!has_next) break;
        PG8_ZERO_ACC();
        cur = nxt; cA = nA; cB = nB; ++ui;
        if constexpr (ALIGN_EPI) { if (wr == 1) PG8_BAR; }
    }
    PG8_WAIT_V(0);
    if constexpr (!ALIGN_EPI) { if (wr == 0) PG8_BAR; }
    PG8_BAR;
    if constexpr (Epi::AFTER_DRAIN) { E.fused(acc, cur, wr, wc, fr, fq, lds, wid, lane); S.done(cur); }
#undef PG8_ZERO_ACC
#undef PG8_SA
#undef PG8_SB
#undef PG8_STAGE
#undef PG8_LDA
#undef PG8_LDB
#undef PG8_MMA
#undef PG8_WAIT_V
#undef PG8_WAIT_L
#undef PG8_BAR
#undef PG8_SCHED
}
}

constexpr int NWAVES = 8;
constexpr int BATCH = 16, SEQ = 2048, D = 1024, M = BATCH * SEQ, MEML = 256, MEMR = BATCH * MEML;
constexpr int NHS = 12, NKV0 = 3, NCH = 4, HD = 64, FF = 3584, NEXP = 8;
constexpr int N0 = 1536, N1 = 2560;
constexpr int P0_Q = 0, P0_K = 768, P0_V = 1024, P0_QC = 1216;
constexpr int P1_Q = 0, P1_K = 768, P1_V = 1536, P1_QC = 2304;
constexpr float RMS_EPS = 1e-6f, LOG2E = 1.4426950408889634f, QSCALE = 0.125f * LOG2E;
constexpr int SLOTS = 2 * M + NEXP * 256, TMAX = SLOTS / 256;
constexpr int CHT = 128, NCHUNK = 3;
#if MOE_FP8
constexpr int PH_FINAL = 16;
constexpr int TAIL_TILE0 = 256, TAIL_SLOT0 = TAIL_TILE0 * 256;
#else
constexpr int PH_FINAL = 19;
#endif
constexpr float XS_SCALE = 8.f, WGU_SCALE = 256.f, H_SCALE = 16.f, WDN_SCALE = 512.f;
constexpr int NPHASE = PH_FINAL + 1;

constexpr size_t MiB = 1u << 20;
constexpr size_t WS_CTL = 0, CTL_ZERO_BYTES = 1 * MiB;
constexpr size_t WS_TAB = 1 * MiB;
constexpr size_t TAB_ROWSC = 0, TAB_CSG = 128 * 1024, TAB_CSU = 160 * 1024, TAB_CS1 = 192 * 1024, TAB_CS0 = 208 * 1024, TAB_ROWSC0 = 384 * 1024;
constexpr size_t TAB_TOKE = 0, TAB_TOKW = 128 * 1024, TAB_TOKSLOT = 384 * 1024, TAB_WOFF = 640 * 1024, TAB_WGH = 704 * 1024, TAB_EST = 712 * 1024, TAB_SLOTW = 720 * 1024;
constexpr size_t WS_MIX = 2 * MiB;
#if MOE_FP8
constexpr size_t WS_W1GU = 2 * MiB, WS_W1DOWN = 58 * MiB;
constexpr size_t WS_RES = 86 * MiB;
constexpr size_t WS_XS = 184 * MiB;
constexpr size_t WS_XN8U = 152 * MiB;
constexpr size_t WS_YS = 152 * MiB;
constexpr size_t WS_HID8 = 284 * MiB;
#else
constexpr size_t WS_W1GU = 2 * MiB, WS_W1DOWN = 114 * MiB;
constexpr size_t WS_XS = 170 * MiB, WS_YS = 170 * MiB;
#endif
constexpr size_t WS_XN = 170 * MiB;
constexpr size_t WS_ROPE = 250 * MiB, WS_MEMKV = 258 * MiB;
constexpr size_t WS_W0IN = 266 * MiB, WS_W0OUT = 271 * MiB, WS_W0GU = 273 * MiB, WS_W0DOWN = 287 * MiB, WS_W1IN = 294 * MiB, WS_W1OUT = 299 * MiB;
constexpr size_t WS_HID = 302 * MiB;
constexpr size_t WS_PROJ = 302 * MiB, WS_ATT = 462 * MiB, WS_END = 526 * MiB;
#if MOE_FP8
static_assert(WS_W1GU + (size_t)NEXP * 2 * FF * D <= WS_W1DOWN && WS_W1DOWN + (size_t)NEXP * D * FF <= WS_RES && WS_RES + (size_t)M * D * 2 <= WS_XN8U && WS_XN8U + (size_t)M * D <= WS_XS && WS_XS + (size_t)SLOTS * D <= WS_HID8 && WS_MIX + (size_t)M * D * 2 <= WS_RES && WS_RES + (size_t)M * D * 2 <= WS_XN && WS_YS + (size_t)SLOTS * D * 2 <= WS_HID8 && WS_HID8 + (size_t)SLOTS * FF <= WS_END, "d_ws map (fp8 experts)");
#else
static_assert(WS_XS + (size_t)SLOTS * D * 2 <= WS_HID && WS_W1DOWN + (size_t)NEXP * D * FF * 2 <= WS_XS, "d_ws map (bf16 experts)");
#endif
static_assert(WS_W1OUT + 2 * MiB <= WS_HID && WS_HID + (size_t)M * FF * 2 <= WS_END, "d_ws map");
constexpr int CW_TMO = 0, CW_BAR = 4096, CW_CMAX = 131072, CW_CMAX1 = CW_CMAX + 2 * FF;

constexpr int RING_OFF = 0, RING_BYTES = 131072;
constexpr int LDSCTL_OFF = RING_BYTES, MISC_OFF = LDSCTL_OFF + 320;
constexpr int ETAB_OFF = MISC_OFF + 128;
constexpr int LDS_BYTES = 147456;
static_assert(ETAB_OFF + 512 <= LDS_BYTES, "LDS map");

#define GAS __attribute__((address_space(1)))
#define LAS __attribute__((address_space(3)))
typedef unsigned short bf16;
typedef unsigned v4u __attribute__((ext_vector_type(4)));
typedef unsigned v2u __attribute__((ext_vector_type(2)));
typedef float f32x4 __attribute__((ext_vector_type(4)));
typedef GAS unsigned gu32;
#define RLX_AGENT __ATOMIC_RELAXED, __HIP_MEMORY_SCOPE_AGENT
#define LDS_WAIT() asm volatile("s_waitcnt lgkmcnt(0)" ::: "memory")
#define VM_WAIT() asm volatile("s_waitcnt vmcnt(0)" ::: "memory")
__device__ __forceinline__ unsigned f2bf(float f) { unsigned u = __builtin_bit_cast(unsigned, f); return (u + 0x7fffu + ((u >> 16) & 1u)) >> 16; }
__device__ __forceinline__ unsigned pk2(float lo, float hi) { return f2bf(lo) | (f2bf(hi) << 16); }
__device__ __forceinline__ float bflo(unsigned w) { return __uint_as_float(w << 16); }
__device__ __forceinline__ float bfhi(unsigned w) { return __uint_as_float(w & 0xffff0000u); }
template <class T> __device__ __forceinline__ const GAS T* vptr(const T* p) { unsigned long long a = (unsigned long long)p; unsigned lo = (unsigned)a, hi = (unsigned)(a >> 32); asm volatile("" : "+v"(lo), "+v"(hi)); return (const GAS T*)(((unsigned long long)hi << 32) | lo); }

#define XB_TMO      128
#define XB_XCNT(j)  (256  + 64 * (j))
#define XB_XSUB(j)  (1280 + 64 * (j))
#define XB_XGEN(j)  (2304 + 64 * (j))
#define XB_TOP      3328
#define XB_TOPGEN   3392
#define XCD_BAR_WORDS 3456
#define XB_SPIN_CAP (1u << 22)

__device__ __forceinline__ unsigned xb_ld(unsigned* p)              { return __hip_atomic_load(p, __ATOMIC_RELAXED, __HIP_MEMORY_SCOPE_AGENT); }
__device__ __forceinline__ unsigned xb_add(unsigned* p, unsigned v) { return __hip_atomic_fetch_add(p, v, __ATOMIC_RELAXED, __HIP_MEMORY_SCOPE_AGENT); }
__device__ __forceinline__ unsigned xb_xcc_id() { return (unsigned)__builtin_amdgcn_s_getreg((3 << 11) | 20) & 0xFu; }
#define XB_SPIN(cond, bar) do { unsigned _sp = 0; while (cond) { __builtin_amdgcn_s_sleep(1); \
    if ((++_sp & 255u) == 0u) { if (xb_ld(&(bar)[XB_TMO])) break; if (_sp > XB_SPIN_CAP) { atomicAdd(&(bar)[XB_TMO], 1u); break; } } } } while (0)

struct XcdBarrier {
    unsigned* bar; unsigned x;
    volatile LAS unsigned* st;
};

__device__ __forceinline__ XcdBarrier xcd_barrier_post(unsigned* bar, volatile LAS unsigned* st) {
    XcdBarrier b; b.bar = bar; b.x = xb_xcc_id(); b.st = st;
    if (threadIdx.x == 0) (void)xb_add(&bar[XB_XCNT(b.x)], 1u);
    return b;
}
__device__ __forceinline__ void xcd_barrier_complete(unsigned* bar, unsigned x, unsigned& nloc, unsigned& nx) {
    const unsigned G = gridDim.x * gridDim.y * gridDim.z;
    unsigned sum, cnt, mine, sp = 0u;
    for (;;) {
        sum = 0u; cnt = 0u; mine = 0u;
#pragma unroll
        for (unsigned j = 0; j < 16; ++j) { const unsigned c = xb_ld(&bar[XB_XCNT(j)]); sum += c; cnt += (c > 0u) ? 1u : 0u; mine = (j == x) ? c : mine; }
        if (sum == G) break;
        __builtin_amdgcn_s_sleep(1);
        if ((++sp & 255u) == 0u) { if (xb_ld(&bar[XB_TMO])) break; if (sp > XB_SPIN_CAP) { atomicAdd(&bar[XB_TMO], 1u); break; } }
    }
    nloc = mine > 0u ? mine : 1u; nx = cnt > 0u ? cnt : 1u;
}

__device__ __forceinline__ void xcd_barrier(const XcdBarrier& b) {
    asm volatile("s_waitcnt vmcnt(0)" ::: "memory");
    __syncthreads();
    if (threadIdx.x == 0) {
        unsigned* bar = b.bar;
        __builtin_amdgcn_s_waitcnt(0);
        unsigned nloc = b.st[0], nx = b.st[1];
        if (nloc == 0u) { xcd_barrier_complete(bar, b.x, nloc, nx); b.st[0] = nloc; b.st[1] = nx; }
        const unsigned old = xb_add(&bar[XB_XSUB(b.x)], 1u);
        const unsigned gen = old / nloc;
        if (old + 1u == (gen + 1u) * nloc) {
            __builtin_amdgcn_fence(__ATOMIC_RELEASE, "agent");
            asm volatile("s_waitcnt vmcnt(0)" ::: "memory");
            const unsigned og = xb_add(&bar[XB_TOP], 1u);
            const unsigned tg = og / nx;
            if (og + 1u == (tg + 1u) * nx) xb_add(&bar[XB_TOPGEN], 1u);
            else XB_SPIN(xb_ld(&bar[XB_TOPGEN]) == tg, bar);
            __builtin_amdgcn_fence(__ATOMIC_ACQUIRE, "agent");
            xb_add(&bar[XB_XGEN(b.x)], 1u);
            asm volatile("s_waitcnt vmcnt(0)" ::: "memory");
        } else {
            XB_SPIN(xb_ld(&bar[XB_XGEN(b.x)]) == gen, bar);
            __builtin_amdgcn_fence(__ATOMIC_ACQUIRE, "agent");
            asm volatile("s_waitcnt vmcnt(0)" ::: "memory");
        }
    }
    __syncthreads();
}

struct Args { const void* in[27]; float* out; unsigned char* ws; int ph_lo, ph_hi, li, pad; };
struct Frame {
    LAS unsigned char* lds; volatile LAS unsigned* MISC; gu32* ctl;
    int tid, lane, wave, G, c;
    unsigned char* ws; float* out;
};
__device__ __forceinline__ void refresh_ids(Frame& F) { int l; asm volatile("v_mbcnt_lo_u32_b32 %0, -1, 0\n\tv_mbcnt_hi_u32_b32 %0, -1, %0" : "=v"(l)); F.lane = l; F.tid = F.wave * 64 + l; }
__device__ __forceinline__ float wave_sum(float v) {
#pragma unroll
    for (int o = 1; o < 64; o <<= 1) v += __shfl_xor(v, o);
    return v;
}
__device__ __forceinline__ int wave_sum_i(int v) {
#pragma unroll
    for (int o = 1; o < 64; o <<= 1) v += __shfl_xor(v, o);
    return v;
}
__device__ __forceinline__ void ld_row_f32(const float* row, int lane, f32x4 (&v)[4]) {
#pragma unroll
    for (int j = 0; j < 4; ++j) v[j] = *(const f32x4*)(row + 4 * lane + 256 * j);
}
__device__ __forceinline__ void st_row_f32(float* row, int lane, const f32x4 (&v)[4]) {
#pragma unroll
    for (int j = 0; j < 4; ++j) *(f32x4*)(row + 4 * lane + 256 * j) = v[j];
}
__device__ __forceinline__ void ld_row_bf16(const bf16* row, int lane, f32x4 (&v)[4]) {
#pragma unroll
    for (int j = 0; j < 4; ++j) { const v2u w = *(const v2u*)(row + 4 * lane + 256 * j); v[j] = (f32x4){bflo(w.x), bfhi(w.x), bflo(w.y), bfhi(w.y)}; }
}
__device__ __forceinline__ void st_row_bf16(bf16* row, int lane, const f32x4 (&v)[4]) {
#pragma unroll
    for (int j = 0; j < 4; ++j) { v2u w; w.x = pk2(v[j][0], v[j][1]); w.y = pk2(v[j][2], v[j][3]); *(v2u*)(row + 4 * lane + 256 * j) = w; }
}
__device__ __forceinline__ void ld_row_f32_nt(const float* row, int lane, f32x4 (&v)[4]) {
#pragma unroll
    for (int j = 0; j < 4; ++j) v[j] = __builtin_nontemporal_load((const f32x4*)(row + 4 * lane + 256 * j));
}
__device__ __forceinline__ void st_row_f32_nt(float* row, int lane, const f32x4 (&v)[4]) {
#pragma unroll
    for (int j = 0; j < 4; ++j) __builtin_nontemporal_store(v[j], (f32x4*)(row + 4 * lane + 256 * j));
}
__device__ __forceinline__ void ld_row_bf16_nt(const bf16* row, int lane, f32x4 (&v)[4]) {
#pragma unroll
    for (int j = 0; j < 4; ++j) { const v2u w = __builtin_nontemporal_load((const v2u*)(row + 4 * lane + 256 * j)); v[j] = (f32x4){bflo(w.x), bfhi(w.x), bflo(w.y), bfhi(w.y)}; }
}
__device__ __forceinline__ void st_row_bf16_nt(bf16* row, int lane, const f32x4 (&v)[4]) {
#pragma unroll
    for (int j = 0; j < 4; ++j) { v2u w; w.x = pk2(v[j][0], v[j][1]); w.y = pk2(v[j][2], v[j][3]); __builtin_nontemporal_store(w, (v2u*)(row + 4 * lane + 256 * j)); }
}
__device__ __forceinline__ float row_rstd(const f32x4 (&v)[4]) {
    float s = 0.f;
#pragma unroll
    for (int j = 0; j < 4; ++j) s += (v[j][0] * v[j][0] + v[j][1] * v[j][1]) + (v[j][2] * v[j][2] + v[j][3] * v[j][3]);
    return 1.0f / sqrtf(wave_sum(s) * (1.0f / D) + RMS_EPS);
}

struct ColSrc { const float* W; int N; int col; float scale; };
struct MapIn0 { const float* W;
    __device__ __forceinline__ ColSrc operator()(int n) const { ColSrc s; s.W = W; s.N = 1408; s.scale = 1.f; s.col = 0;
        if (n < 960) { const int h = n >> 6, p = n & 63; s.col = h * 64 + ((p >> 2) & 1) * 32 + (p >> 5) * 16 + ((p >> 3) & 3) * 4 + (p & 3); if (n < 768) s.scale = QSCALE; }
        else if (n < 1024) s.W = nullptr;
        else if (n < 1216) s.col = 960 + (n - 1024);
        else if (n < 1472) { s.col = 1152 + (n - 1216); s.scale = QSCALE; }
        else s.W = nullptr;
        return s; } };
struct MapIdent { const float* W; int N; int lo_end, hi_begin; float s_edge, s_mid;
    __device__ __forceinline__ ColSrc operator()(int n) const { ColSrc s; s.W = W; s.N = N; s.col = n; s.scale = (n < lo_end || n >= hi_begin) ? s_edge : s_mid; return s; } };
struct MapGU { const float* g; const float* u; float sc;
    __device__ __forceinline__ ColSrc operator()(int n) const { ColSrc s; const int j = n >> 8, r = n & 255; const long long du = (long long)((const char*)u - (const char*)g);
        s.W = (const float*)((const char*)g + (r < 128 ? 0ll : du)); s.N = FF; s.col = 128 * j + (r & 127); s.scale = sc; return s; } };
__device__ __forceinline__ unsigned pk4_i8(float a, float b, float c, float d) {
    const int qa = (int)__builtin_rintf(__builtin_amdgcn_fmed3f(a, -127.f, 127.f)), qb = (int)__builtin_rintf(__builtin_amdgcn_fmed3f(b, -127.f, 127.f)), qc = (int)__builtin_rintf(__builtin_amdgcn_fmed3f(c, -127.f, 127.f)), qd = (int)__builtin_rintf(__builtin_amdgcn_fmed3f(d, -127.f, 127.f));
    return ((unsigned)qa & 0xffu) | (((unsigned)qb & 0xffu) << 8) | (((unsigned)qc & 0xffu) << 16) | ((unsigned)qd << 24); }
struct MapGUq { const float* g; const float* u; const unsigned* cmax;
    __device__ __forceinline__ ColSrc operator()(int n) const { ColSrc s; const int j = n >> 8, r = n & 255, isu = r >> 7; const long long du = (long long)((const char*)u - (const char*)g);
        s.W = (const float*)((const char*)g + (isu ? du : 0ll)); s.N = FF; s.col = 128 * j + (r & 127);
        const float am = __uint_as_float(__hip_atomic_load(cmax + isu * FF + s.col, __ATOMIC_RELAXED, __HIP_MEMORY_SCOPE_AGENT)); s.scale = am > 0.f ? 127.0f / am : 0.f; return s; } };
struct MapIdentQ { const float* W; int N; const unsigned* cmax;
    __device__ __forceinline__ ColSrc operator()(int n) const { ColSrc s; s.W = W; s.N = N; s.col = n; const float am = __uint_as_float(__hip_atomic_load(cmax + n, __ATOMIC_RELAXED, __HIP_MEMORY_SCOPE_AGENT)); s.scale = am > 0.f ? 127.0f / am : 0.f; return s; } };
template <class Map> struct MapScaled { Map inner; float sc;
    __device__ __forceinline__ ColSrc operator()(int n) const { ColSrc s = inner(n); s.scale = sc; return s; } };
template <int OM  , class Map> __device__ __forceinline__ void transpose_item(const Map& map, int K, void* WT, int nblk, LAS float* scr, int item, int lane) {
    constexpr bool FP8 = (OM != 0); constexpr int KT = FP8 ? 128 : 64, KC = FP8 ? 16 : 8, SH = FP8 ? 4 : 3;
    const int kb = item / nblk, nb = item % nblk, k0 = KT * kb, n0 = 32 * nb;
    const ColSrc cs = map(n0 + pg8::perm32(lane & 31));
    float v[KT / 2];
    if (cs.W) { const float* src = cs.W + (size_t)(k0 + (lane >> 5)) * cs.N + cs.col;
#pragma unroll
        for (int i = 0; i < KT / 2; ++i) v[i] = __builtin_nontemporal_load(src + (size_t)(2 * i) * cs.N); }
    else {
#pragma unroll
        for (int i = 0; i < KT / 2; ++i) v[i] = 0.f; }
#pragma unroll
    for (int i = 0; i < KT / 2; ++i) { const int kk = 2 * i + (lane >> 5); scr[kk * 32 + (((lane & 31) + 4 * (kk >> SH)) & 31)] = v[i] * cs.scale; }
    LDS_WAIT(); asm volatile("" ::: "memory");
    const int c = lane & 7;
#pragma unroll
    for (int j = 0; j < 4; ++j) { const int n = (lane >> 3) + 8 * j; const LAS float* s = scr + (KC * c) * 32 + ((n + 4 * c) & 31);
        v4u o;
        if (OM == 2) { o.x = pk4_i8(s[0 * 32], s[1 * 32], s[2 * 32], s[3 * 32]); o.y = pk4_i8(s[4 * 32], s[5 * 32], s[6 * 32], s[7 * 32]); o.z = pk4_i8(s[8 * 32], s[9 * 32], s[10 * 32], s[11 * 32]); o.w = pk4_i8(s[12 * 32], s[13 * 32], s[14 * 32], s[15 * 32]);
            *(GAS v4u*)((unsigned char*)WT + (size_t)(n0 + n) * K + k0 + 16 * c) = o; }
        else if (FP8) { o.x = pg8::pk4_fp8(s[0 * 32], s[1 * 32], s[2 * 32], s[3 * 32]); o.y = pg8::pk4_fp8(s[4 * 32], s[5 * 32], s[6 * 32], s[7 * 32]); o.z = pg8::pk4_fp8(s[8 * 32], s[9 * 32], s[10 * 32], s[11 * 32]); o.w = pg8::pk4_fp8(s[12 * 32], s[13 * 32], s[14 * 32], s[15 * 32]);
            *(GAS v4u*)((unsigned char*)WT + (size_t)(n0 + n) * K + k0 + 16 * c) = o; }
        else { o.x = pk2(s[0 * 32], s[1 * 32]); o.y = pk2(s[2 * 32], s[3 * 32]); o.z = pk2(s[4 * 32], s[5 * 32]); o.w = pk2(s[6 * 32], s[7 * 32]);
            *(GAS v4u*)((bf16*)WT + (size_t)(n0 + n) * K + k0 + 8 * c) = o; } }
    LDS_WAIT(); asm volatile("" ::: "memory");
}

__device__ __forceinline__ void p0_prologue(const Args& a, Frame& F, int part, int gw, int NGW) {
    LAS float* scr = (LAS float*)(F.lds + RING_OFF + F.wave * 16384);
    constexpr int I_IN0 = 16 * 48, I_KV = 16 * 16, I_OUT = 16 * 32, I_GU = 16 * 224, I_DN = 56 * 32, I_IN1 = 16 * 80;
    constexpr int NITEMS = I_IN0 + 2 * I_KV + 2 * I_OUT + I_GU + I_DN + I_IN1;
    bf16* w0in = (bf16*)(F.ws + WS_W0IN);
    for (int it = gw; it < NITEMS; it += NGW) {
        int r = it;
        { const bool kvitem = it >= I_IN0 && it < I_IN0 + 2 * I_KV; if ((part == 1 && !kvitem) || (part == 2 && kvitem)) continue; }
#if PROJ0_I8
        if (r < I_IN0 + 2 * I_KV) {
            if (r >= 80) continue;
            const int nb = r, n = 32 * nb + pg8::perm32(F.lane & 31);
            ColSrc cs; float extra = 1.f;
            if (nb < 48) { cs = MapIn0{(const float*)a.in[5]}(n); extra = cs.scale; }
            else if (nb < 64) cs = MapIdent{(const float*)a.in[6], 512, 0, 1 << 30, 1.f, 1.f}(n - 1536);
            else cs = MapIdent{(const float*)a.in[18], 512, 0, 1 << 30, 1.f, 1.f}(n - 2048);
            float am = 0.f;
            if (cs.W) { const float* src = cs.W + (size_t)(F.lane >> 5) * cs.N + cs.col;
                for (int k = 0; k < 512; k += 32) {
#pragma unroll
                    for (int i = 0; i < 32; ++i) am = fmaxf(am, fabsf(src[(size_t)(2 * (k + i)) * cs.N])); } }
            am = fmaxf(am, __shfl_xor(am, 32));
            const float sc = am > 0.f ? 127.0f / am : 0.f;
            if (F.lane < 32) ((float*)(F.ws + WS_TAB + TAB_CS0))[32 * nb + pg8::perm32(F.lane)] = am * (1.0f / 127.0f) * extra;
            for (int kb = 0; kb < 8; ++kb) {
                if (nb < 48) transpose_item<2>(MapScaled<MapIn0>{MapIn0{(const float*)a.in[5]}, sc}, D, (unsigned char*)w0in, 80, scr, kb * 80 + nb, F.lane);
                else if (nb < 64) transpose_item<2>(MapScaled<MapIdent>{MapIdent{(const float*)a.in[6], 512, 0, 1 << 30, 1.f, 1.f}, sc}, D, (unsigned char*)w0in + (size_t)1536 * D, 16, scr, kb * 16 + (nb - 48), F.lane);
                else transpose_item<2>(MapScaled<MapIdent>{MapIdent{(const float*)a.in[18], 512, 0, 1 << 30, 1.f, 1.f}, sc}, D, (unsigned char*)w0in + (size_t)2048 * D, 16, scr, kb * 16 + (nb - 64), F.lane); }
            continue; } r -= I_IN0 + 2 * I_KV;
#else
        if (r < I_IN0) { transpose_item<0>(MapIn0{(const float*)a.in[5]}, D, w0in, 48, scr, r, F.lane); continue; } r -= I_IN0;
        if (r < I_KV) { transpose_item<0>(MapIdent{(const float*)a.in[6], 512, 0, 1 << 30, 1.f, 1.f}, D, w0in + (size_t)1536 * D, 16, scr, r, F.lane); continue; } r -= I_KV;
        if (r < I_KV) { transpose_item<0>(MapIdent{(const float*)a.in[18], 512, 0, 1 << 30, 1.f, 1.f}, D, w0in + (size_t)2048 * D, 16, scr, r, F.lane); continue; } r -= I_KV;
#endif
        if (r < I_OUT) { transpose_item<0>(MapIdent{(const float*)a.in[8], D, 0, 1 << 30, 1.f, 1.f}, D, (bf16*)(F.ws + WS_W0OUT), 32, scr, r, F.lane); continue; } r -= I_OUT;
        if (r < I_OUT) { transpose_item<0>(MapIdent{(const float*)a.in[19], D, 0, 1 << 30, 1.f, 1.f}, D, (bf16*)(F.ws + WS_W1OUT), 32, scr, r, F.lane); continue; } r -= I_OUT;
#if FFN0_MODE == 2
        if (r < I_GU) {
            const int isu = r >= I_GU / 2, rr = r - isu * (I_GU / 2), kb = rr / 112, nb = rr % 112; const float* W = (const float*)a.in[11 + isu] + (size_t)(64 * kb + (F.lane >> 5)) * FF + 32 * nb + (F.lane & 31);
            float am = 0.f;
#pragma unroll
            for (int i = 0; i < 32; ++i) am = fmaxf(am, fabsf(W[(size_t)(2 * i) * FF]));
            am = fmaxf(am, __shfl_xor(am, 32));
            if (F.lane < 32) atomicMax((unsigned*)(F.ctl + CW_CMAX) + isu * FF + 32 * nb + F.lane, __float_as_uint(am));
            continue; } r -= I_GU;
#else
        if (r < I_GU) { transpose_item<0>(MapGU{(const float*)a.in[11], (const float*)a.in[12], 1.f}, D, (bf16*)(F.ws + WS_W0GU), 224, scr, r, F.lane); continue; } r -= I_GU;
#endif
#if DOWN0_FP8 && FFN0_MODE == 2
        if (r < I_DN) { if (r < I_DN / 2) transpose_item<1>(MapIdent{(const float*)a.in[13], D, 0, 1 << 30, 1.f, WDN_SCALE}, FF, F.ws + WS_W0DOWN, 32, scr, r, F.lane); continue; } r -= I_DN;
#else
        if (r < I_DN) { transpose_item<0>(MapIdent{(const float*)a.in[13], D, 0, 1 << 30, 1.f, 1.f}, FF, (bf16*)(F.ws + WS_W0DOWN), 32, scr, r, F.lane); continue; } r -= I_DN;
#endif
#if PROJ1_I8
        {
            const int kb = r / 80, nb = r % 80; const float* W = (const float*)a.in[17] + (size_t)(64 * kb + (F.lane >> 5)) * N1 + 32 * nb + (F.lane & 31);
            float am = 0.f;
#pragma unroll
            for (int i = 0; i < 32; ++i) am = fmaxf(am, fabsf(W[(size_t)(2 * i) * N1]));
            am = fmaxf(am, __shfl_xor(am, 32));
            if (F.lane < 32) atomicMax((unsigned*)(F.ctl + CW_CMAX1) + 32 * nb + F.lane, __float_as_uint(am)); }
#else
        transpose_item<0>(MapIdent{(const float*)a.in[17], N1, 768, 2304, QSCALE, 1.f}, D, (bf16*)(F.ws + WS_W1IN), 80, scr, r, F.lane);
#endif
    }
    bf16* xn = (bf16*)(F.ws + WS_XN);
#if !PROJ0_I8
    if (part != 1) {
        f32x4 gx[4]; ld_row_f32((const float*)a.in[3], F.lane, gx);
        for (int r = gw; r < M; r += 4 * NGW) { f32x4 v[4][4];
#pragma unroll
            for (int q = 0; q < 4; ++q) { const int rq = r + q * NGW < M ? r + q * NGW : r; ld_row_f32_nt((const float*)a.in[0] + (size_t)rq * D, F.lane, v[q]); }
#pragma unroll
            for (int q = 0; q < 4; ++q) { const float rs = row_rstd(v[q]);
#pragma unroll
                for (int j = 0; j < 4; ++j) v[q][j] = v[q][j] * rs * gx[j];
                if (r + q * NGW < M) st_row_bf16(xn + (size_t)(r + q * NGW) * D, F.lane, v[q]); } } }
    for (int r = M + gw; r < (part == 2 ? M : M + 2 * MEMR); r += NGW) {
#else
    for (int r = (part == 1 ? M : 0) + gw; r < (part == 2 ? M : M + 2 * MEMR); r += NGW) {
#endif
        const float* src; const float* g;
        if (r < M) { src = (const float*)a.in[0] + (size_t)r * D; g = (const float*)a.in[3]; }
        else if (r < M + MEMR) { src = (const float*)a.in[1] + (size_t)(r - M) * D; g = (const float*)a.in[4]; }
        else { src = (const float*)a.in[1] + (size_t)(r - M - MEMR) * D; g = (const float*)a.in[16]; }
        f32x4 v[4], gv[4]; ld_row_f32_nt(src, F.lane, v); ld_row_f32(g, F.lane, gv);
        const float rs = row_rstd(v);
#pragma unroll
        for (int j = 0; j < 4; ++j) v[j] = v[j] * rs * gv[j];
#if PROJ0_I8
        {   float am = 0.f;
#pragma unroll
            for (int j = 0; j < 4; ++j) am = fmaxf(fmaxf(am, fmaxf(fabsf(v[j][0]), fabsf(v[j][1]))), fmaxf(fabsf(v[j][2]), fabsf(v[j][3])));
#pragma unroll
            for (int o = 1; o < 64; o <<= 1) am = fmaxf(am, __shfl_xor(am, o));
            const float inv = am > 0.f ? 127.0f / am : 0.f;
#pragma unroll
            for (int j = 0; j < 4; ++j) *(unsigned*)((unsigned char*)xn + (size_t)r * D + 4 * F.lane + 256 * j) = pk4_i8(v[j][0] * inv, v[j][1] * inv, v[j][2] * inv, v[j][3] * inv);
            if (F.lane == 0) ((float*)(F.ws + WS_TAB + TAB_ROWSC0))[r] = am * (1.0f / 127.0f); }
#else
        st_row_bf16(xn + (size_t)r * D, F.lane, v);
#endif
    }
    float* rope = (float*)(F.ws + WS_ROPE); const int* pos = (const int*)a.in[2];
    if (part != 1)
    for (int idx = gw * 64 + F.lane; idx < M * 32; idx += NGW * 64) {
        const int m = idx >> 5, i = idx & 31;
        const float inv_freq = exp2f(-(float)i * (13.287712379549449f / 32.0f));
        const float ang = (float)pos[m] * inv_freq;
        const double rev = (double)ang * 0.15915494309189535; const float fr = (float)(rev - floor(rev));
        rope[(size_t)m * 64 + i] = __builtin_amdgcn_cosf(fr); rope[(size_t)m * 64 + 32 + i] = __builtin_amdgcn_sinf(fr);
    }
}

template <int XM> __device__ __forceinline__ void norm_res_tail(Frame& F, size_t m, f32x4 (&v)[4], f32x4 (&h)[4], const f32x4 (&gn)[4], bf16* xn, float* rowscale) {
    const float rs2 = row_rstd(h);
#pragma unroll
    for (int j = 0; j < 4; ++j) v[j] = h[j] * rs2 * gn[j];
    if (XM == 2) { float am = 0.f;
#pragma unroll
        for (int j = 0; j < 4; ++j) am = fmaxf(fmaxf(am, fmaxf(fabsf(v[j][0]), fabsf(v[j][1]))), fmaxf(fabsf(v[j][2]), fabsf(v[j][3])));
#pragma unroll
        for (int o = 1; o < 64; o <<= 1) am = fmaxf(am, __shfl_xor(am, o));
        const float inv = am > 0.f ? 127.0f / am : 0.f;
#pragma unroll
        for (int j = 0; j < 4; ++j) *(unsigned*)((unsigned char*)xn + m * D + 4 * F.lane + 256 * j) = pk4_i8(v[j][0] * inv, v[j][1] * inv, v[j][2] * inv, v[j][3] * inv);
        if (F.lane == 0) rowscale[m] = am * (1.0f / 127.0f); }
    else st_row_bf16(xn + m * D, F.lane, v);
}
template <int XM, bool HB> __device__ __forceinline__ void phase_norm_res(Frame& F, const bf16* mix, const void* hin_, const float* gpost, const float* gnext, bf16* xn, float* rowscale) {
    const float* hin = (const float*)hin_; const bf16* hinb = (const bf16*)hin_; bf16* res = (bf16*)(F.ws + WS_RES);
    f32x4 gp[4], gn[4]; ld_row_f32(gpost, F.lane, gp); ld_row_f32(gnext, F.lane, gn);
    for (int i = 0; i < 16; i += 4) { const size_t m0 = (size_t)(128 * F.c + 16 * F.wave + i);
        f32x4 v[4][4], h[4][4];
#pragma unroll
        for (int q = 0; q < 4; ++q) { ld_row_bf16_nt(mix + (m0 + q) * D, F.lane, v[q]); if (HB) ld_row_bf16_nt(hinb + (m0 + q) * D, F.lane, h[q]); else ld_row_f32_nt(hin + (m0 + q) * D, F.lane, h[q]); }
#pragma unroll
        for (int q = 0; q < 4; ++q) { const float rs = row_rstd(v[q]);
#pragma unroll
            for (int j = 0; j < 4; ++j) h[q][j] = h[q][j] + v[q][j] * rs * gp[j];
            st_row_bf16_nt(res + (m0 + q) * D, F.lane, h[q]);
            norm_res_tail<XM>(F, m0 + q, v[q], h[q], gn, xn, rowscale); } }
}
__device__ __forceinline__ void phase_route(const Args& a, Frame& F, bf16* res_out) {
    const bf16* mix = (const bf16*)(F.ws + WS_MIX); const float* wr = (const float*)a.in[22];
    int* tok_e = (int*)(F.ws + WS_TAB + TAB_TOKE); float* tok_w = (float*)(F.ws + WS_TAB + TAB_TOKW);
    int* woff = (int*)(F.ws + WS_TAB + TAB_WOFF); int* wgh = (int*)(F.ws + WS_TAB + TAB_WGH);
    f32x4 gp[4], gn[4]; ld_row_f32((const float*)a.in[20], F.lane, gp); ld_row_f32((const float*)a.in[21], F.lane, gn);
    unsigned long long cnt = 0ull;
    f32x4 wA[16], wB[16];
#pragma unroll
    for (int j = 0; j < 4; ++j)
#pragma unroll
        for (int q = 0; q < 4; ++q) { const float* wp = wr + (size_t)(4 * F.lane + 256 * j + q) * 8; wA[4 * j + q] = *(const f32x4*)wp; wB[4 * j + q] = *(const f32x4*)(wp + 4); }
    const size_t m0 = (size_t)(128 * F.c + 16 * F.wave); const bf16* resin = (const bf16*)(F.ws + WS_RES);
    v2u rv[2][4], rh[2][4];
#pragma unroll
    for (int j = 0; j < 4; ++j) { rv[0][j] = __builtin_nontemporal_load((const v2u*)(mix + m0 * D + 4 * F.lane + 256 * j)); rh[0][j] = __builtin_nontemporal_load((const v2u*)(resin + m0 * D + 4 * F.lane + 256 * j)); }
#pragma unroll
    for (int i = 0; i < 16; ++i) { const size_t m = m0 + i; const int cur = i & 1, nx = cur ^ 1;
        if (i + 1 < 16) {
#pragma unroll
            for (int j = 0; j < 4; ++j) { rv[nx][j] = __builtin_nontemporal_load((const v2u*)(mix + (m + 1) * D + 4 * F.lane + 256 * j)); rh[nx][j] = __builtin_nontemporal_load((const v2u*)(resin + (m + 1) * D + 4 * F.lane + 256 * j)); } }
        f32x4 v[4], h[4];
#pragma unroll
        for (int j = 0; j < 4; ++j) { v[j] = (f32x4){bflo(rv[cur][j].x), bfhi(rv[cur][j].x), bflo(rv[cur][j].y), bfhi(rv[cur][j].y)}; h[j] = (f32x4){bflo(rh[cur][j].x), bfhi(rh[cur][j].x), bflo(rh[cur][j].y), bfhi(rh[cur][j].y)}; }
        const float rs = row_rstd(v);
#pragma unroll
        for (int j = 0; j < 4; ++j) h[j] = h[j] + v[j] * rs * gp[j];
        st_row_bf16_nt(res_out + m * D, F.lane, h);
        const float rs2 = row_rstd(h);
        float lg[8];
#pragma unroll
        for (int e = 0; e < 8; ++e) lg[e] = 0.f;
#pragma unroll
        for (int j = 0; j < 4; ++j) { const f32x4 x = h[j] * rs2 * gn[j];
#if MOE_FP8
            *(unsigned*)(F.ws + WS_XN8U + m * D + 4 * F.lane + 256 * j) = pg8::pk4_fp8(x[0] * XS_SCALE, x[1] * XS_SCALE, x[2] * XS_SCALE, x[3] * XS_SCALE);
#endif
#pragma unroll
            for (int q = 0; q < 4; ++q) { const f32x4 w0 = wA[4 * j + q], w1 = wB[4 * j + q];
                lg[0] += x[q] * w0[0]; lg[1] += x[q] * w0[1]; lg[2] += x[q] * w0[2]; lg[3] += x[q] * w0[3]; lg[4] += x[q] * w1[0]; lg[5] += x[q] * w1[1]; lg[6] += x[q] * w1[2]; lg[7] += x[q] * w1[3]; } }
#pragma unroll
        for (int e = 0; e < 8; ++e) lg[e] = wave_sum(lg[e]);
        int e0 = 0; float v0 = lg[0];
#pragma unroll
        for (int e = 1; e < 8; ++e) if (lg[e] > v0) { v0 = lg[e]; e0 = e; }
        int e1 = -1; float v1 = -INFINITY;
#pragma unroll
        for (int e = 0; e < 8; ++e) if (e != e0 && lg[e] > v1) { v1 = lg[e]; e1 = e; }
        if (e1 < 0) e1 = (e0 + 1) & 7;
        const float ex = __expf(v1 - v0), w0 = 1.0f / (1.0f + ex), w1 = ex * w0;
        const unsigned r0 = (unsigned)(cnt >> (8 * e0)) & 0xffu; cnt += 1ull << (8 * e0);
        const unsigned r1 = (unsigned)(cnt >> (8 * e1)) & 0xffu; cnt += 1ull << (8 * e1);
        if (F.lane == 0) { tok_e[m] = e0 | (e1 << 4) | (int)(r0 << 8) | (int)(r1 << 16); tok_w[2 * m] = w0; tok_w[2 * m + 1] = w1; } }
    LAS unsigned* wh = (LAS unsigned*)(F.lds + RING_OFF);
    if (F.lane < 8) wh[F.wave * 8 + F.lane] = (unsigned)(cnt >> (8 * F.lane)) & 0xffu;
    __syncthreads();
    if (F.tid < 8) { unsigned run = 0u;
        for (int w = 0; w < 8; ++w) { woff[(F.c * 8 + w) * 8 + F.tid] = (int)run; run += wh[w * 8 + F.tid]; }
        wgh[F.c * 8 + F.tid] = (int)run; }
    __syncthreads();
}
__device__ __forceinline__ void phase_permute(const Args& a, Frame& F) {
    const int* tok_e = (const int*)(F.ws + WS_TAB + TAB_TOKE); const float* tok_w = (const float*)(F.ws + WS_TAB + TAB_TOKW);
    int* tok_slot = (int*)(F.ws + WS_TAB + TAB_TOKSLOT); const int* woff = (const int*)(F.ws + WS_TAB + TAB_WOFF); const int* wgh = (const int*)(F.ws + WS_TAB + TAB_WGH);
    int* est_g = (int*)(F.ws + WS_TAB + TAB_EST); float* slot_w = (float*)(F.ws + WS_TAB + TAB_SLOTW);
    LAS int* part = (LAS int*)(F.lds + RING_OFF);
    LAS int* basew = (LAS int*)(F.lds + RING_OFF + 1024);
    if (F.tid < 256) {
        int hv[8];
#pragma unroll
        for (int e = 0; e < 8; ++e) hv[e] = wgh[F.tid * 8 + e];
#pragma unroll
        for (int e = 0; e < 8; ++e) { const int tot = wave_sum_i(hv[e]), pre = wave_sum_i(F.tid < F.c ? hv[e] : 0);
            if (F.lane == 0) { part[F.wave * 16 + e] = tot; part[F.wave * 16 + 8 + e] = pre; } }
    }
    __syncthreads();
    int est[9], pre[8]; est[0] = 0;
#pragma unroll
    for (int e = 0; e < 8; ++e) { const int tot = part[e] + part[16 + e] + part[32 + e] + part[48 + e]; pre[e] = part[8 + e] + part[24 + e] + part[40 + e] + part[56 + e]; est[e + 1] = est[e] + ((tot + 255) & ~255); }
    if (F.c == 0 && F.tid == 0) {
#pragma unroll
        for (int k = 0; k < 9; ++k) est_g[k] = est[k];
    }
    if (F.lane < 8) { int b = 0;
#pragma unroll
        for (int e = 0; e < 8; ++e) if (F.lane == e) b = est[e] + pre[e];
        basew[F.wave * 8 + F.lane] = b + woff[(F.c * 8 + F.wave) * 8 + F.lane]; }
    LDS_WAIT(); asm volatile("" ::: "memory");
    bf16* xs = (bf16*)(F.ws + WS_XS);
#if MOE_FP8
    {
        const size_t mb = (size_t)(128 * F.c + 16 * F.wave);
        unsigned w[16][4]; int sa[16], sb[16];
#pragma unroll
        for (int i = 0; i < 16; ++i) {
#pragma unroll
            for (int j = 0; j < 4; ++j) w[i][j] = __builtin_nontemporal_load((const unsigned*)(F.ws + WS_XN8U + (mb + i) * D + 4 * F.lane + 256 * j)); }
#pragma unroll
        for (int i = 0; i < 16; ++i) { const size_t m = mb + i;
            const int te = tok_e[m]; const int e0 = te & 15, e1 = (te >> 4) & 15, r0 = (te >> 8) & 255, r1 = (te >> 16) & 255;
            sa[i] = basew[F.wave * 8 + e0] + r0; sb[i] = basew[F.wave * 8 + e1] + r1;
            if (F.lane == 0) { tok_slot[2 * m] = sa[i]; tok_slot[2 * m + 1] = sb[i]; slot_w[sa[i]] = tok_w[2 * m]; slot_w[sb[i]] = tok_w[2 * m + 1]; } }
#pragma unroll
        for (int i = 0; i < 16; ++i) {
#pragma unroll
            for (int j = 0; j < 4; ++j) { *(unsigned*)((unsigned char*)xs + (size_t)sa[i] * D + 4 * F.lane + 256 * j) = w[i][j]; *(unsigned*)((unsigned char*)xs + (size_t)sb[i] * D + 4 * F.lane + 256 * j) = w[i][j]; } }
    }
#else
    f32x4 gn[4]; ld_row_f32((const float*)a.in[21], F.lane, gn);
    for (int i = 0; i < 16; ++i) { const size_t m = (size_t)(128 * F.c + 16 * F.wave + i);
        const int te = tok_e[m]; const int e0 = te & 15, e1 = (te >> 4) & 15, r0 = (te >> 8) & 255, r1 = (te >> 16) & 255;
        const int s0 = basew[F.wave * 8 + e0] + r0, s1 = basew[F.wave * 8 + e1] + r1;
        if (F.lane == 0) { tok_slot[2 * m] = s0; tok_slot[2 * m + 1] = s1; slot_w[s0] = tok_w[2 * m]; slot_w[s1] = tok_w[2 * m + 1]; }
        f32x4 h[4]; ld_row_bf16((const bf16*)(F.ws + WS_RES) + m * D, F.lane, h);
        const float rs = row_rstd(h);
#pragma unroll
        for (int j = 0; j < 4; ++j) h[j] = h[j] * rs * gn[j];
        st_row_bf16(xs + (size_t)s0 * D, F.lane, h); st_row_bf16(xs + (size_t)s1 * D, F.lane, h); }
#endif
    __syncthreads();
    LAS float* scr = (LAS float*)(F.lds + RING_OFF + F.wave * 16384);
    const int gw = F.c * NWAVES + F.wave, NGW = F.G * NWAVES;
#if MOE_FP8
    constexpr int I_GU = 8 * 224, I_DN = 28 * 32, I_E = I_GU + I_DN;
    for (int it = gw; it < NEXP * I_E; it += NGW) { const int e = it / I_E, r = it % I_E;
        if (r < I_GU) transpose_item<1>(MapGU{(const float*)a.in[23] + (size_t)e * D * FF, (const float*)a.in[24] + (size_t)e * D * FF, WGU_SCALE}, D, F.ws + WS_W1GU + (size_t)e * 2 * FF * D, 224, scr, r, F.lane);
        else transpose_item<1>(MapIdent{(const float*)a.in[25] + (size_t)e * FF * D, D, 0, 1 << 30, 1.f, WDN_SCALE}, FF, F.ws + WS_W1DOWN + (size_t)e * D * FF, 32, scr, r - I_GU, F.lane); }
#else
    constexpr int I_GU = 16 * 224, I_DN = 56 * 32, I_E = I_GU + I_DN;
    for (int it = gw; it < NEXP * I_E; it += NGW) { const int e = it / I_E, r = it % I_E;
        if (r < I_GU) transpose_item<0>(MapGU{(const float*)a.in[23] + (size_t)e * D * FF, (const float*)a.in[24] + (size_t)e * D * FF, 1.f}, D, (bf16*)(F.ws + WS_W1GU) + (size_t)e * 2 * FF * D, 224, scr, r, F.lane);
        else transpose_item<0>(MapIdent{(const float*)a.in[25] + (size_t)e * FF * D, D, 0, 1 << 30, 1.f, 1.f}, FF, (bf16*)(F.ws + WS_W1DOWN) + (size_t)e * D * FF, 32, scr, r - I_GU, F.lane); }
#endif
}
__device__ __forceinline__ int build_expert_table(Frame& F) {
    const GAS int* est_g = vptr((const int*)(F.ws + WS_TAB + TAB_EST));
    int est[9];
#pragma unroll
    for (int k = 0; k < 9; ++k) est[k] = est_g[k];
    LAS unsigned char* tab = F.lds + ETAB_OFF;
    if (F.tid < TMAX) { const int r = F.tid * 256; int e = 0;
#pragma unroll
        for (int k = 1; k < 8; ++k) e += (r >= est[k]) ? 1 : 0;
        tab[F.tid] = (unsigned char)e; }
    __syncthreads();
    return __builtin_amdgcn_readfirstlane(est[8]) >> 8;
}
__device__ __forceinline__ void final_row(const bf16* ys, size_t m, int s0, int s1, const f32x4 (&gp)[4], Frame& F, bool poison) {
    const float qnan = __builtin_nanf("");
    f32x4 y0[4], y1[4], h[4]; ld_row_bf16_nt(ys + (size_t)s0 * D, F.lane, y0); ld_row_bf16_nt(ys + (size_t)s1 * D, F.lane, y1); ld_row_bf16_nt((const bf16*)(F.ws + WS_RES) + m * D, F.lane, h);
#pragma unroll
    for (int j = 0; j < 4; ++j) y0[j] = y0[j] + y1[j];
    const float rs = row_rstd(y0);
#pragma unroll
    for (int j = 0; j < 4; ++j) { h[j] = h[j] + y0[j] * rs * gp[j]; if (poison) h[j] = (f32x4){qnan, qnan, qnan, qnan}; }
    st_row_f32_nt(F.out + m * D, F.lane, h);
}
__device__ __forceinline__ void final_row2(const bf16* ys, size_t ma, int a0, int a1, size_t mb, int b0, int b1, const f32x4 (&gp)[4], Frame& F, bool poison) {
    const float qnan = __builtin_nanf("");
    f32x4 ya0[4], ya1[4], ha[4], yb0[4], yb1[4], hb[4];
    ld_row_bf16_nt(ys + (size_t)a0 * D, F.lane, ya0); ld_row_bf16_nt(ys + (size_t)a1 * D, F.lane, ya1); ld_row_bf16_nt((const bf16*)(F.ws + WS_RES) + ma * D, F.lane, ha);
    ld_row_bf16_nt(ys + (size_t)b0 * D, F.lane, yb0); ld_row_bf16_nt(ys + (size_t)b1 * D, F.lane, yb1); ld_row_bf16_nt((const bf16*)(F.ws + WS_RES) + mb * D, F.lane, hb);
#pragma unroll
    for (int j = 0; j < 4; ++j) { ya0[j] = ya0[j] + ya1[j]; yb0[j] = yb0[j] + yb1[j]; }
    const float rsa = row_rstd(ya0), rsb = row_rstd(yb0);
#pragma unroll
    for (int j = 0; j < 4; ++j) { ha[j] = ha[j] + ya0[j] * rsa * gp[j]; hb[j] = hb[j] + yb0[j] * rsb * gp[j]; if (poison) { ha[j] = (f32x4){qnan, qnan, qnan, qnan}; hb[j] = ha[j]; } }
    st_row_f32_nt(F.out + ma * D, F.lane, ha); st_row_f32_nt(F.out + mb * D, F.lane, hb);
}
__device__ __forceinline__ void final_rows4(const bf16* ys, const size_t (&mrow)[4], const int (&s0)[4], const int (&s1)[4], const bool (&st)[4], const f32x4 (&gp)[4], Frame& F, bool poison) {
    const float qnan = __builtin_nanf(""); const bf16* resb = (const bf16*)(F.ws + WS_RES);
    v2u ry0[4][4], ry1[4][4], rh[4][4];
#pragma unroll
    for (int q = 0; q < 4; ++q)
#pragma unroll
        for (int j = 0; j < 4; ++j) { ry0[q][j] = __builtin_nontemporal_load((const v2u*)(ys + (size_t)s0[q] * D + 4 * F.lane + 256 * j)); ry1[q][j] = __builtin_nontemporal_load((const v2u*)(ys + (size_t)s1[q] * D + 4 * F.lane + 256 * j));
            rh[q][j] = __builtin_nontemporal_load((const v2u*)(resb + mrow[q] * D + 4 * F.lane + 256 * j)); }
#pragma unroll
    for (int q = 0; q < 4; ++q) { f32x4 y[4], h[4];
#pragma unroll
        for (int j = 0; j < 4; ++j) { y[j] = (f32x4){bflo(ry0[q][j].x), bfhi(ry0[q][j].x), bflo(ry0[q][j].y), bfhi(ry0[q][j].y)} + (f32x4){bflo(ry1[q][j].x), bfhi(ry1[q][j].x), bflo(ry1[q][j].y), bfhi(ry1[q][j].y)};
            h[j] = (f32x4){bflo(rh[q][j].x), bfhi(rh[q][j].x), bflo(rh[q][j].y), bfhi(rh[q][j].y)}; }
        const float rs = row_rstd(y);
#pragma unroll
        for (int j = 0; j < 4; ++j) { h[j] = h[j] + y[j] * rs * gp[j]; if (poison) h[j] = (f32x4){qnan, qnan, qnan, qnan}; }
        if (st[q]) st_row_f32_nt(F.out + mrow[q] * D, F.lane, h); }
}
__device__ __forceinline__ void phase_final(const Args& a, Frame& F, bool poison, int mode, int nskip) {
    const bf16* ys = (const bf16*)(F.ws + WS_YS); const int* tok_slot = (const int*)(F.ws + WS_TAB + TAB_TOKSLOT);
    f32x4 gp[4]; ld_row_f32((const float*)a.in[26], F.lane, gp);
#if MOE_FP8
    if (mode == 0) {
        const int stride = (F.G - nskip) * NWAVES, base = (F.c - nskip) * NWAVES + F.wave, nrows = (M - base + stride - 1) / stride;
        int s0v = 0, s1v = 0; if (F.lane < nrows) { const size_t mk = (size_t)base + (size_t)F.lane * stride; s0v = tok_slot[2 * mk]; s1v = tok_slot[2 * mk + 1]; }
        for (int k = 0; k < nrows; k += 4) { size_t mrow[4]; int s0[4], s1[4]; bool st[4];
#pragma unroll
            for (int q = 0; q < 4; ++q) { const int kk = (k + q < nrows) ? k + q : nrows - 1; int a0 = __builtin_amdgcn_readlane(s0v, kk), a1 = __builtin_amdgcn_readlane(s1v, kk);
                const bool tail = a0 >= TAIL_SLOT0 || a1 >= TAIL_SLOT0; st[q] = (k + q < nrows) && !tail; if (tail) { a0 = 0; a1 = 0; }
                s0[q] = a0; s1[q] = a1; mrow[q] = (size_t)base + (size_t)kk * stride; }
            final_rows4(ys, mrow, s0, s1, st, gp, F, poison); } }
    else {
        const size_t mb = (size_t)(128 * F.c + 16 * F.wave); int s0v = 0, s1v = 0; if (F.lane < 16) { s0v = tok_slot[2 * (mb + F.lane)]; s1v = tok_slot[2 * (mb + F.lane) + 1]; }
        unsigned long long todo = __ballot(F.lane < 16 && (s0v >= TAIL_SLOT0 || s1v >= TAIL_SLOT0));
        while (todo) { const int i = __builtin_ctzll(todo); todo &= todo - 1;
            final_row(ys, mb + i, __builtin_amdgcn_readlane(s0v, i), __builtin_amdgcn_readlane(s1v, i), gp, F, poison); } }
#else
    for (int i = 0; i < 16; ++i) { const size_t m = (size_t)(128 * F.c + 16 * F.wave + i); final_row(ys, m, tok_slot[2 * m], tok_slot[2 * m + 1], gp, F, poison); }
#endif
}

namespace att {
using bf16x8 = __attribute__((ext_vector_type(8))) short;
using s16x4 = __attribute__((ext_vector_type(4))) short;
using f32x16 = __attribute__((ext_vector_type(16))) float;
using u32x4 = __attribute__((ext_vector_type(4))) unsigned;
typedef LAS const char* lds_cptr;
constexpr int SLOTB = 8192;
constexpr int L_K = 0, L_V = 4 * SLOTB, L_WS = 8 * SLOTB, L_OST = L_WS + 8 * 256, L_FLAG = L_OST + 8 * 4096, L_END = L_FLAG + 64;
static_assert(L_END <= RING_BYTES, "attention LDS map");
#define SBAR() __builtin_amdgcn_sched_barrier(0)
#define WAIT_BAR(N) asm volatile("s_waitcnt vmcnt(" #N ") lgkmcnt(0)\n\ts_barrier" ::: "memory")
#define WAIT_BAR_L() asm volatile("s_waitcnt lgkmcnt(0)\n\ts_barrier" ::: "memory")
__device__ __forceinline__ int crow(int r, int hi) { return (r & 3) + 8 * (r >> 2) + 4 * hi; }
__device__ __forceinline__ void glds16(const void* gsrc, unsigned lds_dst) { unsigned keep;
    asm volatile("s_mov_b32 %0, m0\n\ts_mov_b32 m0, %2\n\ts_nop 0\n\tglobal_load_lds_dwordx4 %1, off\n\ts_mov_b32 m0, %0" : "=&s"(keep) : "v"(gsrc), "s"(lds_dst) : "memory"); }
__device__ __forceinline__ unsigned cvtpk(float lo, float hi) { unsigned r; asm volatile("v_cvt_pk_bf16_f32 %0, %1, %2" : "=v"(r) : "v"(lo), "v"(hi)); return r; }
__device__ __forceinline__ float swap_max(float m) { auto rr = __builtin_amdgcn_permlane32_swap(__float_as_uint(m), __float_as_uint(m), false, false); return fmaxf(__uint_as_float(rr[0]), __uint_as_float(rr[1])); }
__device__ __forceinline__ float swap_sum(float m) { auto rr = __builtin_amdgcn_permlane32_swap(__float_as_uint(m), __float_as_uint(m), false, false); return __uint_as_float(rr[0]) + __uint_as_float(rr[1]); }

struct KV { const bf16* K; const bf16* V; int ld; };
__device__ __forceinline__ void dma_k(const KV& kv, int key0, unsigned lds0, int slot, int wid, int lane) {
    glds16(kv.K + (size_t)(key0 + lane) * kv.ld + wid * 8, (unsigned)__builtin_amdgcn_readfirstlane(lds0 + L_K + slot * SLOTB + wid * 1024)); }
__device__ __forceinline__ void dma_v(const KV& kv, int key0, unsigned lds0, int slot, int wid, int lane) {
    glds16(kv.V + (size_t)(key0 + 16 * (wid & 3) + (lane >> 2)) * kv.ld + (wid >> 2) * 32 + (lane & 3) * 8, (unsigned)__builtin_amdgcn_readfirstlane(lds0 + L_V + slot * SLOTB + wid * 1024)); }
__device__ __forceinline__ void load_q(bf16x8 (&qr)[4], const bf16* Qrow0, int ld, int r32, int hi) {
#pragma unroll
    for (int d0 = 0; d0 < 4; ++d0) qr[d0] = *(const bf16x8*)(Qrow0 + (size_t)r32 * ld + d0 * 16 + hi * 8);
}
__device__ __forceinline__ void qkt(f32x16& p0, f32x16& p1, lds_cptr Kslot, const bf16x8 (&qr)[4], int r32, int hi) {
    const lds_cptr kb = Kslot + hi * 1024 + r32 * 16;
    f32x16 z0 = f32x16{}, z1 = f32x16{};
#pragma unroll
    for (int d0 = 0; d0 < 4; ++d0) {
        const bf16x8 b0 = *(LAS const bf16x8*)(kb + d0 * 2048);
        const bf16x8 b1 = *(LAS const bf16x8*)(kb + d0 * 2048 + 512);
        z0 = __builtin_amdgcn_mfma_f32_32x32x16_bf16(b0, qr[d0], z0, 0, 0, 0); z1 = __builtin_amdgcn_mfma_f32_32x32x16_bf16(b1, qr[d0], z1, 0, 0, 0); }
    p0 = z0; p1 = z1;
}
__device__ __forceinline__ void pv(f32x16 (&o)[2], int vb, bf16x8 pa0, bf16x8 pa1, bf16x8 pa2, bf16x8 pa3) {
#pragma unroll
    for (int d0 = 0; d0 < 2; ++d0) { s16x4 lo[4], hi[4];
#pragma unroll
        for (int ks = 0; ks < 4; ++ks) {
            asm volatile("ds_read_b64_tr_b16 %0,%1 offset:%c2" : "=&v"(lo[ks]) : "v"(vb), "i"(d0 * 4096 + ks * 1024) : "memory");
            asm volatile("ds_read_b64_tr_b16 %0,%1 offset:%c2" : "=&v"(hi[ks]) : "v"(vb), "i"(d0 * 4096 + ks * 1024 + 512) : "memory"); }
        asm volatile("s_waitcnt lgkmcnt(0)" ::: "memory"); SBAR();
#define ATT_PK(k) (bf16x8){lo[k][0], lo[k][1], lo[k][2], lo[k][3], hi[k][0], hi[k][1], hi[k][2], hi[k][3]}
        o[d0] = __builtin_amdgcn_mfma_f32_32x32x16_bf16(pa0, ATT_PK(0), o[d0], 0, 0, 0);
        o[d0] = __builtin_amdgcn_mfma_f32_32x32x16_bf16(pa1, ATT_PK(1), o[d0], 0, 0, 0);
        o[d0] = __builtin_amdgcn_mfma_f32_32x32x16_bf16(pa2, ATT_PK(2), o[d0], 0, 0, 0);
        o[d0] = __builtin_amdgcn_mfma_f32_32x32x16_bf16(pa3, ATT_PK(3), o[d0], 0, 0, 0);
#undef ATT_PK
    }
}
__device__ __forceinline__ void pack_p(const f32x16& p0, const f32x16& p1, bf16x8& a0, bf16x8& a1, bf16x8& a2, bf16x8& a3) {
    u32x4 w0 = (u32x4){cvtpk(p0[0], p0[1]), cvtpk(p0[2], p0[3]), cvtpk(p0[4], p0[5]), cvtpk(p0[6], p0[7])}, w1 = (u32x4){cvtpk(p0[8], p0[9]), cvtpk(p0[10], p0[11]), cvtpk(p0[12], p0[13]), cvtpk(p0[14], p0[15])};
    u32x4 w2 = (u32x4){cvtpk(p1[0], p1[1]), cvtpk(p1[2], p1[3]), cvtpk(p1[4], p1[5]), cvtpk(p1[6], p1[7])}, w3 = (u32x4){cvtpk(p1[8], p1[9]), cvtpk(p1[10], p1[11]), cvtpk(p1[12], p1[13]), cvtpk(p1[14], p1[15])};
    a0 = __builtin_bit_cast(bf16x8, w0); a1 = __builtin_bit_cast(bf16x8, w1); a2 = __builtin_bit_cast(bf16x8, w2); a3 = __builtin_bit_cast(bf16x8, w3);
}
__device__ __forceinline__ void store_o(const f32x16 (&o)[2], float l_row, bool normalize, bf16* Orow0, int ldo, LAS unsigned char* shm, int wid, int lane, int r32, int hi) {
    LAS float* wsf = (LAS float*)(shm + L_WS) + wid * 64;
    float rli[16];
    if (normalize) { if (hi == 0) wsf[32 + r32] = l_row; asm volatile("s_waitcnt lgkmcnt(0)" ::: "memory");
#pragma unroll
        for (int r = 0; r < 16; ++r) rli[r] = __builtin_amdgcn_rcpf(wsf[32 + crow(r, hi)]); }
    else {
#pragma unroll
        for (int r = 0; r < 16; ++r) rli[r] = 1.0f; }
    LAS bf16* stg = (LAS bf16*)(shm + L_OST) + wid * 2048;
#pragma unroll
    for (int r = 0; r < 16; ++r) { const int orow = crow(r, hi);
#pragma unroll
        for (int d0 = 0; d0 < 2; ++d0) stg[orow * 64 + d0 * 32 + r32] = (bf16)f2bf(o[d0][r] * rli[r]); }
    asm volatile("s_waitcnt lgkmcnt(0)" ::: "memory");
#pragma unroll
    for (int i = 0; i < 4; ++i) { const int row = i * 8 + (lane >> 3), ch = lane & 7; const u32x4 v = *(LAS const u32x4*)(stg + row * 64 + ch * 8); *(u32x4*)(Orow0 + (size_t)row * ldo + ch * 8) = v; }
    asm volatile("s_waitcnt lgkmcnt(0)" ::: "memory");
}

template <bool MASK> __device__ __forceinline__ void softmax_task(LAS unsigned char* shm, unsigned lds0, const bf16x8 (&qr)[4], int jlo, int jhi, int tq, float m_init, bool has_sink,
                                                                  f32x16 (&o)[2], float& l_out, int lane, int r32, int hi) {
    const lds_cptr shm3 = (lds_cptr)shm;
    const int vb0 = (int)(lds0 + L_V) + ((lane >> 4) & 1) * 32 + (lane & 3) * 8 + (4 * hi + ((lane & 15) >> 2)) * 64;
    float m = m_init;
    for (int j = jlo; j <= jhi; ++j) { f32x16 p0, p1; qkt(p0, p1, shm3 + L_K + j * SLOTB, qr, r32, hi);
        float a = -INFINITY;
#pragma unroll
        for (int r = 0; r < 16; ++r) { const int kk = 64 * j + crow(r, hi); float s0 = p0[r], s1 = p1[r];
            if (MASK) { if (kk < tq + 1 || kk > tq + 128) s0 = -INFINITY; if (kk + 32 < tq + 1 || kk + 32 > tq + 128) s1 = -INFINITY; }
            a = fmaxf(a, fmaxf(s0, s1)); }
        m = fmaxf(m, a); }
    m = swap_max(m);
    if (!(m > -1e30f)) m = 0.f;
    float l = 0.f; o[0] = f32x16{}; o[1] = f32x16{};
    for (int j = jlo; j <= jhi; ++j) { f32x16 p0, p1; qkt(p0, p1, shm3 + L_K + j * SLOTB, qr, r32, hi);
#pragma unroll
        for (int r = 0; r < 16; ++r) { const int kk = 64 * j + crow(r, hi); float s0 = p0[r], s1 = p1[r];
            if (MASK) { if (kk < tq + 1 || kk > tq + 128) s0 = -INFINITY; if (kk + 32 < tq + 1 || kk + 32 > tq + 128) s1 = -INFINITY; }
            p0[r] = __builtin_amdgcn_exp2f(s0 - m); p1[r] = __builtin_amdgcn_exp2f(s1 - m); l += p0[r] + p1[r]; }
        bf16x8 a0, a1, a2, a3; pack_p(p0, p1, a0, a1, a2, a3);
        pv(o, vb0 + j * SLOTB, a0, a1, a2, a3); }
    l = swap_sum(l);
    if (has_sink) l += __builtin_amdgcn_exp2f(m_init - m);
    l_out = l;
}
__device__ __forceinline__ void swa_task_online(LAS unsigned char* shm, unsigned lds0, const bf16x8 (&qr)[4], int jlo, int jhi, int jmid, int tq, float m_init,
                                                f32x16 (&o)[2], float& l_out, int wid, int lane, int r32, int hi) {
    const lds_cptr shm3 = (lds_cptr)shm;
    const int vb0 = (int)(lds0 + L_V) + ((lane >> 4) & 1) * 32 + (lane & 3) * 8 + (4 * hi + ((lane & 15) >> 2)) * 64;
    LAS float* wsf = (LAS float*)(shm + L_WS) + wid * 64;
    float m = m_init, l = 0.f; o[0] = f32x16{}; o[1] = f32x16{};
    for (int j = jlo; j <= jhi; ++j) { f32x16 p0, p1; qkt(p0, p1, shm3 + L_K + j * SLOTB, qr, r32, hi);
        if (j == jmid - 1) {
#pragma unroll
            for (int r = 0; r < 16; ++r) { const int kk = 64 * j + crow(r, hi); if (kk < tq + 1) p0[r] = -INFINITY; if (kk + 32 < tq + 1) p1[r] = -INFINITY; } }
        else if (j != jmid) {
#pragma unroll
            for (int r = 0; r < 16; ++r) { const int kk = 64 * j + crow(r, hi); if (kk > tq + 128) p0[r] = -INFINITY; if (kk + 32 > tq + 128) p1[r] = -INFINITY; } }
        float a = -INFINITY;
#pragma unroll
        for (int r = 0; r < 16; ++r) a = fmaxf(a, fmaxf(p0[r], p1[r]));
        const float mn = fmaxf(m, swap_max(a));
        if (!__all(mn - m <= 8.0f)) { const float al = __builtin_amdgcn_exp2f(m - mn); m = mn;
            if (hi == 0) wsf[r32] = al;
            l = l * al;
            asm volatile("s_waitcnt lgkmcnt(0)" ::: "memory");
#pragma unroll
            for (int g = 0; g < 4; ++g) { const f32x4 f = *(LAS const f32x4*)(wsf + 8 * g + 4 * hi);
#pragma unroll
                for (int k = 0; k < 4; ++k) { o[0][4 * g + k] *= f[k]; o[1][4 * g + k] *= f[k]; } } }
        float ps = 0.f;
#pragma unroll
        for (int r = 0; r < 16; ++r) { p0[r] = __builtin_amdgcn_exp2f(p0[r] - m); p1[r] = __builtin_amdgcn_exp2f(p1[r] - m); ps += p0[r] + p1[r]; }
        l = l + ps;
        bf16x8 a0, a1, a2, a3; pack_p(p0, p1, a0, a1, a2, a3);
        pv(o, vb0 + j * SLOTB, a0, a1, a2, a3); }
    l = swap_sum(l) + __builtin_amdgcn_exp2f(m_init - m);
    l_out = l;
}
__device__ __forceinline__ void swa_phase(Frame& F, const float* sinks) {
    const bf16* P = (const bf16*)(F.ws + WS_PROJ); bf16* O = (bf16*)(F.ws + WS_ATT);
    LAS unsigned char* shm = F.lds + RING_OFF; const unsigned lds0 = (unsigned)(size_t)shm;
    const int lane = F.lane, r32 = lane & 31, hi = lane >> 5, wid = F.wave;
    for (int u = F.c; u < BATCH * NKV0 * 16; u += F.G) {
        const int qb = u & 15, kvh = (u >> 4) % NKV0, b = u / (16 * NKV0);
        const size_t row0 = (size_t)b * SEQ;
        KV kv{P + row0 * N0 + P0_K + kvh * 64, P + row0 * N0 + P0_V + kvh * 64, N0};
        const int jfirst = qb == 0 ? 2 : 0;
        for (int j = jfirst; j < 4; ++j) { dma_k(kv, 128 * qb - 128 + 64 * j, lds0, j, wid, lane); dma_v(kv, 128 * qb - 128 + 64 * j, lds0, j, wid, lane); }
        bf16x8 qa[4], qb2[4];
        const int ta = wid, tb = wid + 8;
        const int ha = 4 * kvh + (ta >> 2), hb = 4 * kvh + (tb >> 2), q0a = 32 * (ta & 3), q0b = 32 * (tb & 3);
        load_q(qa, P + (row0 + 128 * qb + q0a) * N0 + P0_Q + ha * 64, N0, r32, hi);
        load_q(qb2, P + (row0 + 128 * qb + q0b) * N0 + P0_Q + hb * 64, N0, r32, hi);
        WAIT_BAR(0);
        {   const int jlo = (q0a + 1) >> 6, jhi = (q0a + 159) >> 6; f32x16 o[2]; float l;
            swa_task_online(shm, lds0, qa, jlo < jfirst ? jfirst : jlo, jhi, jlo + 1, q0a + r32, sinks[ha] * LOG2E, o, l, wid, lane, r32, hi);
            store_o(o, l, true, O + (row0 + 128 * qb + q0a) * D + ha * 64, D, shm, wid, lane, r32, hi); }
        {   const int jlo = (q0b + 1) >> 6, jhi = (q0b + 159) >> 6; f32x16 o[2]; float l;
            swa_task_online(shm, lds0, qb2, jlo < jfirst ? jfirst : jlo, jhi, jlo + 1, q0b + r32, sinks[hb] * LOG2E, o, l, wid, lane, r32, hi);
            store_o(o, l, true, O + (row0 + 128 * qb + q0b) * D + hb * 64, D, shm, wid, lane, r32, hi); }
        WAIT_BAR(0);
    }
}
__device__ __forceinline__ void cross_phase(Frame& F, const bf16* P, int ldp, int qoff, const bf16* KVm) {
    bf16* O = (bf16*)(F.ws + WS_ATT);
    LAS unsigned char* shm = F.lds + RING_OFF; const unsigned lds0 = (unsigned)(size_t)shm;
    const int lane = F.lane, r32 = lane & 31, hi = lane >> 5, wid = F.wave;
    const int per = (BATCH * NCH * 8 + F.G - 1) / F.G; int loaded = -1;
    for (int u = F.c * per; u < (F.c + 1) * per && u < BATCH * NCH * 8; ++u) {
        const int qb = u & 7, pair = u >> 3, c = pair & 3, b = pair >> 2;
        KV kv{KVm + (size_t)b * MEML * 512 + c * 64, KVm + (size_t)b * MEML * 512 + 256 + c * 64, 512};
        if (pair != loaded) { for (int j = 0; j < 4; ++j) { dma_k(kv, 64 * j, lds0, j, wid, lane); dma_v(kv, 64 * j, lds0, j, wid, lane); } loaded = pair; }
        const size_t qrow = (size_t)b * SEQ + 256 * qb + 32 * wid;
        bf16x8 qr[4]; load_q(qr, P + qrow * ldp + qoff + c * 64, ldp, r32, hi);
        WAIT_BAR(0);
        f32x16 o[2]; float l;
        softmax_task<false>(shm, lds0, qr, 0, 3, 0, -INFINITY, false, o, l, lane, r32, hi);
        store_o(o, l, true, O + qrow * D + NHS * 64 + c * 64, D, shm, wid, lane, r32, hi);
        WAIT_BAR(0);
    }
}
#undef SBAR
}
namespace att {
#define SBAR() __builtin_amdgcn_sched_barrier(0)
constexpr float SB_EXIT = 150.0f;
__device__ __forceinline__ float max0(float a) { float r; asm("v_max_f32_e32 %0, 0, %1" : "=v"(r) : "v"(a)); return r; }
template <bool DIAG> __device__ __forceinline__ void sb_tile(f32x16& p0, f32x16& p1, int key0, int t, float& R, int hi) {
    f32x16 s0, s1;
#pragma unroll
    for (int r = 0; r < 16; ++r) { const float z = p0[r]; float sp = max0(z) + __builtin_amdgcn_logf(1.0f + __builtin_amdgcn_exp2f(-fabsf(z))); if (DIAG && key0 + crow(r, hi) >= t) sp = 0.f; s0[r] = sp; }
    SBAR();
#pragma unroll
    for (int r = 0; r < 16; ++r) { const float z = p1[r]; float sp = max0(z) + __builtin_amdgcn_logf(1.0f + __builtin_amdgcn_exp2f(-fabsf(z))); if (DIAG && key0 + 32 + crow(r, hi) >= t) sp = 0.f; s1[r] = sp; }
    SBAR();
    float G[16];
#pragma unroll
    for (int i = 0; i < 4; ++i) {
        const float g0 = (s0[4 * i] + s0[4 * i + 1]) + (s0[4 * i + 2] + s0[4 * i + 3]), g1 = (s1[4 * i] + s1[4 * i + 1]) + (s1[4 * i + 2] + s1[4 * i + 3]);
        auto r0 = __builtin_amdgcn_permlane32_swap(__float_as_uint(g0), __float_as_uint(g0), false, false); G[2 * i] = __uint_as_float(r0[0]); G[2 * i + 1] = __uint_as_float(r0[1]);
        auto r1 = __builtin_amdgcn_permlane32_swap(__float_as_uint(g1), __float_as_uint(g1), false, false); G[8 + 2 * i] = __uint_as_float(r1[0]); G[8 + 2 * i + 1] = __uint_as_float(r1[1]); }
    float E[16]; E[15] = R;
#pragma unroll
    for (int g = 14; g >= 0; --g) E[g] = E[g + 1] + G[g + 1];
    R = E[0] + G[0];
    SBAR();
#pragma unroll
    for (int i = 0; i < 4; ++i) {
        { float e = hi ? E[2 * i + 1] : E[2 * i];
#pragma unroll
          for (int j = 3; j >= 0; --j) { e += s0[4 * i + j]; float w = __builtin_amdgcn_exp2f(p0[4 * i + j] - e); if (DIAG && key0 + crow(4 * i + j, hi) >= t) w = 0.f; p0[4 * i + j] = w; } }
        { float e = hi ? E[8 + 2 * i + 1] : E[8 + 2 * i];
#pragma unroll
          for (int j = 3; j >= 0; --j) { e += s1[4 * i + j]; float w = __builtin_amdgcn_exp2f(p1[4 * i + j] - e); if (DIAG && key0 + 32 + crow(4 * i + j, hi) >= t) w = 0.f; p1[4 * i + j] = w; } }
    }
}
__device__ __forceinline__ void sb_unit(Frame& F, int b, int h, int qb, int fslot, bool landed, bf16x8 (&qr)[4], bool has_next, int nb, int nh, int nqb, bf16x8 (&qn)[4]) {
    const bf16* P = (const bf16*)(F.ws + WS_PROJ); bf16* O = (bf16*)(F.ws + WS_ATT);
    LAS unsigned char* shm = F.lds + RING_OFF; const unsigned lds0 = (unsigned)(size_t)shm; const lds_cptr shm3 = (lds_cptr)shm;
    const int lane = F.lane, r32 = lane & 31, hi = lane >> 5, wid = F.wave;
    const size_t row0 = (size_t)b * SEQ;
    KV kv{P + row0 * N1 + P1_K + h * 64, P + row0 * N1 + P1_V + h * 64, N1};
    const int NT = 4 * qb + 4, T0 = 256 * qb + 32 * wid, t = T0 + r32;
    const int vb0 = (int)(lds0 + L_V) + ((lane >> 4) & 1) * 32 + (lane & 3) * 8 + (4 * hi + ((lane & 15) >> 2)) * 64;
    LAS unsigned* flag = (LAS unsigned*)(shm + L_FLAG);
    f32x16 o[2]; o[0] = f32x16{}; o[1] = f32x16{};
    float R = 0.f; bool mydone = false;
    for (int i = 0; i < NT; ++i) {
        const int kt = NT - 1 - i, sl = i == 0 ? fslot : (i & 1), nsl = (i + 1) & 1;
        if (i + 1 < NT) { dma_k(kv, 64 * (kt - 1), lds0, nsl, wid, lane); dma_v(kv, 64 * (kt - 1), lds0, nsl, wid, lane); if (!(i == 0 && landed)) WAIT_BAR(2); }
        else WAIT_BAR(0);
        if (i == 0 && has_next) {
            const size_t nrow0 = (size_t)nb * SEQ; KV nkv{P + nrow0 * N1 + P1_K + nh * 64, P + nrow0 * N1 + P1_V + nh * 64, N1};
            dma_k(nkv, 64 * (4 * nqb + 3), lds0, 5 - fslot, wid, lane); dma_v(nkv, 64 * (4 * nqb + 3), lds0, 5 - fslot, wid, lane);
            load_q(qn, P + (nrow0 + 256 * nqb + 32 * wid) * N1 + P1_Q + nh * 64, N1, r32, hi); }
        if (64 * kt <= T0 + 30 && !mydone) {
            f32x16 p0, p1; qkt(p0, p1, shm3 + L_K + sl * SLOTB, qr, r32, hi);
            if (kt >= 4 * qb) sb_tile<true>(p0, p1, 64 * kt, t, R, hi); else sb_tile<false>(p0, p1, 64 * kt, t, R, hi);
            bf16x8 a0, a1, a2, a3; pack_p(p0, p1, a0, a1, a2, a3);
            pv(o, vb0 + sl * SLOTB, a0, a1, a2, a3);
            mydone = __all(R >= SB_EXIT) != 0;
        }
        if (lane == 0) flag[wid] = mydone ? 1u : 0u;
        WAIT_BAR_L();
        unsigned all = 1u;
#pragma unroll
        for (int w = 0; w < 8; ++w) all &= flag[w];
        if (__builtin_amdgcn_readfirstlane(all) != 0u) break;
        asm volatile("s_waitcnt lgkmcnt(0)" ::: "memory");
    }
    WAIT_BAR(0);
    store_o(o, 1.0f, false, O + (row0 + T0) * D + h * 64, D, shm, wid, lane, r32, hi);
}
__device__ __forceinline__ void sb_phase(Frame& F) {
    const bf16* P = (const bf16*)(F.ws + WS_PROJ); const unsigned lds0 = (unsigned)(size_t)(F.lds + RING_OFF);
    const int lane = F.lane, r32 = lane & 31, hi = lane >> 5, wid = F.wave;
    auto coords = [&](int k, int& b, int& h, int& qb) -> bool { const int p = 3 * F.c + (k >> 1); if (k >= 6 || p >= BATCH * NHS * 4) return false; const int bh = p >> 2, s = p & 3; qb = (k & 1) ? 7 - s : s; b = bh / NHS; h = bh % NHS; return true; };
    int b, h, qb; if (!coords(0, b, h, qb)) return;
    bf16x8 qr[4], qn[4];
    {   const size_t row0 = (size_t)b * SEQ; KV kv{P + row0 * N1 + P1_K + h * 64, P + row0 * N1 + P1_V + h * 64, N1};
        dma_k(kv, 64 * (4 * qb + 3), lds0, 2, wid, lane); dma_v(kv, 64 * (4 * qb + 3), lds0, 2, wid, lane);
        load_q(qr, P + (row0 + 256 * qb + 32 * wid) * N1 + P1_Q + h * 64, N1, r32, hi); }
    for (int k = 0; k < 6; ++k) {
        int nb = 0, nh = 0, nqb = 0; const bool has_next = coords(k + 1, nb, nh, nqb);
        sb_unit(F, b, h, qb, 2 + (k & 1), k > 0, qr, has_next, nb, nh, nqb, qn);
        if (!has_next) break;
#pragma unroll
        for (int d = 0; d < 4; ++d) qr[d] = qn[d];
        b = nb; h = nh; qb = nqb;
    }
}
#undef SBAR
}

__global__ void __launch_bounds__(NWAVES * 64, 2) fwd_kernel(Args args) {
    extern __shared__ __attribute__((aligned(16))) unsigned char lds[];
    Frame F;
    F.lds = (LAS unsigned char*)lds; F.MISC = (volatile LAS unsigned*)(F.lds + MISC_OFF);
    F.tid = threadIdx.x; F.lane = F.tid & 63; F.wave = __builtin_amdgcn_readfirstlane(F.tid >> 6);
    F.G = gridDim.x; F.c = blockIdx.x; F.ws = args.ws; F.out = args.out; F.ctl = (gu32*)(args.ws + WS_CTL);
    for (int u = F.tid; u < (LDS_BYTES - LDSCTL_OFF) / 4; u += NWAVES * 64) ((LAS unsigned*)(F.lds + LDSCTL_OFF))[u] = 0u;
    __syncthreads();
    XcdBarrier bar; bar.bar = (unsigned*)(F.ctl + CW_BAR) + args.li * XCD_BAR_WORDS; bar.x = 0; bar.st = nullptr;
    if (!MK_PER_PHASE) bar = xcd_barrier_post((unsigned*)(F.ctl + CW_BAR) + args.li * XCD_BAR_WORDS, F.MISC + 8);
    const int lo = args.ph_lo, hi = args.ph_hi;
#define IN(k) (lo <= (k) && (k) < hi)
#define SEAM(k) do { if (IN(k) && IN((k) + 1)) xcd_barrier(bar); } while (0)
    unsigned char* const ws = args.ws;
    LAS unsigned char* const ring = F.lds + RING_OFF;

    if (IN(0)) { refresh_ids(F);
#if MEMKV_EARLY && !MK_PER_PHASE && !PROJ0_I8
        p0_prologue(args, F, 1, F.c * NWAVES + F.wave, F.G * NWAVES);
        xcd_barrier(bar);
        if (F.c < 64) {
            pg8::Gemm g{(const bf16*)(ws + WS_XN), (const bf16*)(ws + WS_W0IN), 0, 0, D}; pg8::MemOrder S{F.c};
            pg8::EpiProj0 E{(bf16*)(ws + WS_PROJ), (bf16*)(ws + WS_MEMKV), (const float*)(ws + WS_ROPE), (const float*)(ws + WS_TAB + TAB_ROWSC0), (const float*)(ws + WS_TAB + TAB_CS0)};
            pg8::gemm_phase<pg8::EpiProj0, pg8::MemOrder, true, true, 0>(ring, g, S, E, F.wave); }
        else p0_prologue(args, F, 2, (F.c - 64) * NWAVES + F.wave, (F.G - 64) * NWAVES);
#else
        p0_prologue(args, F, 0, F.c * NWAVES + F.wave, F.G * NWAVES);
#endif
        SEAM(0); }
    if (IN(1)) {
#if MEMKV_EARLY && !MK_PER_PHASE && !PROJ0_I8
        pg8::Gemm g{(const bf16*)(ws + WS_XN), (const bf16*)(ws + WS_W0IN), 0, 0, D}; pg8::StaticOrder S; S.init(M, N0, F.G, F.c);
        pg8::EpiProj0 E{(bf16*)(ws + WS_PROJ), (bf16*)(ws + WS_MEMKV), (const float*)(ws + WS_ROPE), (const float*)(ws + WS_TAB + TAB_ROWSC0), (const float*)(ws + WS_TAB + TAB_CS0)};
        pg8::gemm_phase<pg8::EpiProj0, pg8::StaticOrder, true, true, 0>(ring, g, S, E, F.wave);
#else
        pg8::Gemm g{(const bf16*)(ws + WS_XN), (const bf16*)(ws + WS_W0IN), 0, 0, PROJ0_I8 ? D / 2 : D}; pg8::Proj0Order S; S.init(F.G, F.c);
        pg8::EpiProj0 E{(bf16*)(ws + WS_PROJ), (bf16*)(ws + WS_MEMKV), (const float*)(ws + WS_ROPE), (const float*)(ws + WS_TAB + TAB_ROWSC0), (const float*)(ws + WS_TAB + TAB_CS0)};
        pg8::gemm_phase<pg8::EpiProj0, pg8::Proj0Order, true, true, PROJ0_I8 ? 2 : 0>(ring, g, S, E, F.wave);
#endif
        SEAM(1);
    }
    if (IN(2)) { refresh_ids(F);
        att::swa_phase(F, (const float*)args.in[7]);
        att::cross_phase(F, (const bf16*)(ws + WS_PROJ), N0, P0_QC, (const bf16*)(ws + WS_MEMKV));
        SEAM(2); }
    if (IN(3)) {
        pg8::Gemm g{(const bf16*)(ws + WS_ATT), (const bf16*)(ws + WS_W0OUT), 0, 0, D}; pg8::StaticOrder S; S.init(M, D, F.G, F.c);
        pg8::EpiPlain E{(bf16*)(ws + WS_MIX), D, 1.0f};
        pg8::gemm_phase<pg8::EpiPlain, pg8::StaticOrder, true, true>(ring, g, S, E, F.wave);
        SEAM(3);
    }
    if (IN(4)) { refresh_ids(F);
#if FFN0_MODE == 2
        {
            LAS float* scr = (LAS float*)(F.lds + RING_OFF + F.wave * 16384); const int gw = F.c * NWAVES + F.wave, NGW = F.G * NWAVES;
            const unsigned* cmax = (const unsigned*)(F.ctl + CW_CMAX);
            for (int it = gw; it < 8 * 224; it += NGW) transpose_item<2>(MapGUq{(const float*)args.in[11], (const float*)args.in[12], cmax}, D, ws + WS_W0GU, 224, scr, it, F.lane);
            float* csg = (float*)(ws + WS_TAB + TAB_CSG);
            for (int i = F.c * (NWAVES * 64) + F.tid; i < 2 * FF; i += F.G * NWAVES * 64) { const float am = __uint_as_float(__hip_atomic_load(cmax + i, RLX_AGENT)); (i < FF ? csg : (float*)(ws + WS_TAB + TAB_CSU) - FF)[i] = am * (1.0f / 127.0f); }
            __syncthreads(); }
#endif
        phase_norm_res<FFN0_MODE, false>(F, (const bf16*)(ws + WS_MIX), (const void*)args.in[0], (const float*)args.in[9], (const float*)args.in[10], (bf16*)(ws + WS_XN), (float*)(ws + WS_TAB + TAB_ROWSC)); SEAM(4); }
    if (IN(5)) {
#if FFN0_MODE == 2
        pg8::Gemm g{(const bf16*)(ws + WS_XN), (const bf16*)(ws + WS_W0GU), 0, 0, D / 2}; pg8::StaticOrder S; S.init(M, 2 * FF, F.G, F.c);
        pg8::EpiSwigluI8 E{(bf16*)(ws + WS_HID), (const float*)(ws + WS_TAB + TAB_ROWSC), (const float*)(ws + WS_TAB + TAB_CSG), (const float*)(ws + WS_TAB + TAB_CSU), H_SCALE};
        pg8::gemm_phase<pg8::EpiSwigluI8, pg8::StaticOrder, true, true, 2>(ring, g, S, E, F.wave);
#else
        pg8::Gemm g{(const bf16*)(ws + WS_XN), (const bf16*)(ws + WS_W0GU), 0, 0, D}; pg8::StaticOrder S; S.init(M, 2 * FF, F.G, F.c);
        pg8::EpiSwiglu E{(bf16*)(ws + WS_HID)};
        pg8::gemm_phase<pg8::EpiSwiglu, pg8::StaticOrder, true, true>(ring, g, S, E, F.wave);
#endif
        SEAM(5);
    }
    if (IN(6)) {
#if DOWN0_FP8 && FFN0_MODE == 2
        pg8::Gemm g{(const bf16*)(ws + WS_HID), (const bf16*)(ws + WS_W0DOWN), 0, 0, FF / 2}; pg8::StaticOrder S; S.init(M, D, F.G, F.c);
        pg8::EpiPlain E{(bf16*)(ws + WS_MIX), D, 1.0f / (H_SCALE * WDN_SCALE)};
        pg8::gemm_phase<pg8::EpiPlain, pg8::StaticOrder, true, true, 1>(ring, g, S, E, F.wave);
#else
        pg8::Gemm g{(const bf16*)(ws + WS_HID), (const bf16*)(ws + WS_W0DOWN), 0, 0, FF}; pg8::StaticOrder S; S.init(M, D, F.G, F.c);
        pg8::EpiPlain E{(bf16*)(ws + WS_MIX), D, 1.0f};
        pg8::gemm_phase<pg8::EpiPlain, pg8::StaticOrder, true, true>(ring, g, S, E, F.wave);
#endif
        SEAM(6);
    }
    if (IN(7)) { refresh_ids(F);
#if PROJ1_I8
        {
            LAS float* scr = (LAS float*)(F.lds + RING_OFF + F.wave * 16384); const int gw = F.c * NWAVES + F.wave, NGW = F.G * NWAVES;
            const unsigned* cmax = (const unsigned*)(F.ctl + CW_CMAX1);
            for (int it = gw; it < 8 * 80; it += NGW) transpose_item<2>(MapIdentQ{(const float*)args.in[17], N1, cmax}, D, ws + WS_W1IN, 80, scr, it, F.lane);
            float* cs1 = (float*)(ws + WS_TAB + TAB_CS1);
            for (int i = F.c * (NWAVES * 64) + F.tid; i < N1; i += F.G * NWAVES * 64) { const float am = __uint_as_float(__hip_atomic_load(cmax + i, RLX_AGENT)); cs1[i] = am * (1.0f / 127.0f) * ((i < 768 || i >= 2304) ? QSCALE : 1.0f); }
            __syncthreads(); }
        phase_norm_res<2, true>(F, (const bf16*)(ws + WS_MIX), (const void*)(ws + WS_RES), (const float*)args.in[14], (const float*)args.in[15], (bf16*)(ws + WS_XN), (float*)(ws + WS_TAB + TAB_ROWSC)); SEAM(7); }
#else
        phase_norm_res<0, true>(F, (const bf16*)(ws + WS_MIX), (const void*)(ws + WS_RES), (const float*)args.in[14], (const float*)args.in[15], (bf16*)(ws + WS_XN), nullptr); SEAM(7); }
#endif
    if (IN(8)) {
#if PROJ1_I8
        pg8::Gemm g{(const bf16*)(ws + WS_XN), (const bf16*)(ws + WS_W1IN), 0, 0, D / 2}; pg8::StaticOrder S; S.init(M, N1, F.G, F.c);
        pg8::EpiPlainI8 E{(bf16*)(ws + WS_PROJ), N1, (const float*)(ws + WS_TAB + TAB_ROWSC), (const float*)(ws + WS_TAB + TAB_CS1)};
        pg8::gemm_phase<pg8::EpiPlainI8, pg8::StaticOrder, true, true, 2>(ring, g, S, E, F.wave);
#else
        pg8::Gemm g{(const bf16*)(ws + WS_XN), (const bf16*)(ws + WS_W1IN), 0, 0, D}; pg8::StaticOrder S; S.init(M, N1, F.G, F.c);
        pg8::EpiPlain E{(bf16*)(ws + WS_PROJ), N1, 1.0f};
        pg8::gemm_phase<pg8::EpiPlain, pg8::StaticOrder, true, true>(ring, g, S, E, F.wave);
#endif
        SEAM(8);
    }
    if (IN(9)) { refresh_ids(F);
        att::sb_phase(F);
        att::cross_phase(F, (const bf16*)(ws + WS_PROJ), N1, P1_QC, (const bf16*)(ws + WS_MEMKV) + (size_t)MEMR * 512);
        SEAM(9); }
    if (IN(10)) {
        pg8::Gemm g{(const bf16*)(ws + WS_ATT), (const bf16*)(ws + WS_W1OUT), 0, 0, D}; pg8::StaticOrder S; S.init(M, D, F.G, F.c);
        pg8::EpiPlain E{(bf16*)(ws + WS_MIX), D, 1.0f};
        pg8::gemm_phase<pg8::EpiPlain, pg8::StaticOrder, true, true>(ring, g, S, E, F.wave);
        SEAM(10);
    }
#ifdef PROBE_DRY11
    if (IN(11)) { refresh_ids(F); phase_route(args, F, (args.li >= 1 && args.li <= 4) ? (bf16*)(ws + WS_XS) : (bf16*)(ws + WS_RES)); SEAM(11); }
#else
    if (IN(11)) { refresh_ids(F); phase_route(args, F, (bf16*)(ws + WS_RES)); SEAM(11); }
#endif
    if (IN(12)) { refresh_ids(F); phase_permute(args, F); SEAM(12); }
#if MOE_FP8
    if (IN(13)) { refresh_ids(F); const int T = build_expert_table(F);
        pg8::Gemm g{(const bf16*)(ws + WS_XS), (const bf16*)(ws + WS_W1GU), 0, 0, D / 2}; pg8::MoeOrder<false> S; S.init(T, 2 * FF / 256, 0, (const LAS unsigned char*)(F.lds + ETAB_OFF), F.G, F.c);
        pg8::EpiSwiglu8 E{ws + WS_HID8, 1.0f / (XS_SCALE * WGU_SCALE), H_SCALE};
        pg8::gemm_phase<pg8::EpiSwiglu8, pg8::MoeOrder<false>, true, true, 1>(ring, g, S, E, F.wave);
        SEAM(13); }
    if (IN(14)) { refresh_ids(F); const int T = build_expert_table(F);
        pg8::Gemm g{(const bf16*)(ws + WS_HID8), (const bf16*)(ws + WS_W1DOWN), 0, 0, FF / 2}; pg8::MoeOrder<true> S; S.init(T < TAIL_TILE0 ? T : TAIL_TILE0, D / 256, 0, (const LAS unsigned char*)(F.lds + ETAB_OFF), F.G, F.c);
        pg8::EpiMoeDown E{(bf16*)(ws + WS_YS), (const float*)(ws + WS_TAB + TAB_SLOTW), 1.0f / (H_SCALE * WDN_SCALE)};
        pg8::gemm_phase<pg8::EpiMoeDown, pg8::MoeOrder<true>, true, true, 1>(ring, g, S, E, F.wave);
        SEAM(14); }
    if (IN(15)) { refresh_ids(F); const int T = build_expert_table(F); const int ntail = T > TAIL_TILE0 ? T - TAIL_TILE0 : 0, nu = ntail * (D / 256);
        bool poison = false;
        if (!MK_PER_PHASE) for (int li = 0; li <= args.li; ++li) poison |= __hip_atomic_load((unsigned*)(F.ctl + CW_BAR) + li * XCD_BAR_WORDS + XB_TMO, RLX_AGENT) != 0u;
        if (F.c < nu) {
            pg8::Gemm g{(const bf16*)(ws + WS_HID8), (const bf16*)(ws + WS_W1DOWN), 0, 0, FF / 2}; pg8::MoeOrder<true> S; S.init(ntail, D / 256, TAIL_TILE0, (const LAS unsigned char*)(F.lds + ETAB_OFF), F.G, F.c, TAIL_TILE0);
            pg8::EpiMoeDown E{(bf16*)(ws + WS_YS), (const float*)(ws + WS_TAB + TAB_SLOTW), 1.0f / (H_SCALE * WDN_SCALE)};
            pg8::gemm_phase<pg8::EpiMoeDown, pg8::MoeOrder<true>, true, true, 1>(ring, g, S, E, F.wave); }
        else phase_final(args, F, poison, 0, nu);
        SEAM(15); }
#else
#define MOE_CHUNK(ck) \
    if (IN(13 + 2 * (ck))) { refresh_ids(F); const int T = build_expert_table(F); const int t0 = (ck) * CHT; int nM = T - t0; nM = nM < 0 ? 0 : (nM > CHT ? CHT : nM); \
        pg8::Gemm g{(const bf16*)(ws + WS_XS), (const bf16*)(ws + WS_W1GU), 0, 0, D}; pg8::MoeOrder<false> S; S.init(nM, 2 * FF / 256, t0, (const LAS unsigned char*)(F.lds + ETAB_OFF), F.G, F.c); \
        pg8::EpiSwiglu E{(bf16*)(ws + WS_HID)}; \
        pg8::gemm_phase<pg8::EpiSwiglu, pg8::MoeOrder<false>, true, true>(ring, g, S, E, F.wave); \
        SEAM(13 + 2 * (ck)); } \
    if (IN(14 + 2 * (ck))) { refresh_ids(F); const int T = build_expert_table(F); const int t0 = (ck) * CHT; int nM = T - t0; nM = nM < 0 ? 0 : (nM > CHT ? CHT : nM); \
        pg8::Gemm g{(const bf16*)(ws + WS_HID), (const bf16*)(ws + WS_W1DOWN), 0, 0, FF}; pg8::MoeOrder<true> S; S.init(nM, D / 256, t0, (const LAS unsigned char*)(F.lds + ETAB_OFF), F.G, F.c); \
        pg8::EpiMoeDown E{(bf16*)(ws + WS_YS), (const float*)(ws + WS_TAB + TAB_SLOTW), 1.0f}; \
        pg8::gemm_phase<pg8::EpiMoeDown, pg8::MoeOrder<true>, true, true>(ring, g, S, E, F.wave); \
        SEAM(14 + 2 * (ck)); }
    MOE_CHUNK(0)
    MOE_CHUNK(1)
    MOE_CHUNK(2)
#undef MOE_CHUNK
#endif
    if (IN(PH_FINAL)) { refresh_ids(F);
        bool poison = false;
        if (!MK_PER_PHASE) for (int li = 0; li <= args.li; ++li) poison |= __hip_atomic_load((unsigned*)(F.ctl + CW_BAR) + li * XCD_BAR_WORDS + XB_TMO, RLX_AGENT) != 0u;
        phase_final(args, F, poison, 1, 0);
    }
#undef IN
#undef SEAM
#undef MOE_CHUNK
}

extern "C" void kernel_launch(void* const* d_in, const int* in_sizes, int n_in, void* d_out, int out_size, void* d_ws, size_t ws_size, hipStream_t stream) {
    static int grid = 0;
    if (grid == 0) {
        if (n_in != 27 || in_sizes[0] != M * D || out_size != M * D || ws_size < WS_END) { fprintf(stderr, "kernel_launch: shape / workspace mismatch (n_in %d, ws %zu); nothing launched\n", n_in, ws_size); grid = -1; return; }
        int dev = 0, cus = 0;
        if (hipGetDevice(&dev) != hipSuccess || hipDeviceGetAttribute(&cus, hipDeviceAttributeMultiprocessorCount, dev) != hipSuccess) { grid = -1; return; }
        if (hipFuncSetAttribute((const void*)fwd_kernel, hipFuncAttributeMaxDynamicSharedMemorySize, LDS_BYTES) != hipSuccess) { grid = -1; return; }
        (void)hipGetLastError();
        if (cus != 256) { fprintf(stderr, "kernel_launch: built for 256 CUs, found %d; nothing launched\n", cus); grid = -1; return; }
        grid = 256;
    }
    if (grid < 0) return;
    if (hipMemsetAsync((char*)d_ws + WS_CTL, 0, CTL_ZERO_BYTES, stream) != hipSuccess) return;
    Args a{};
    for (int i = 0; i < 27; ++i) a.in[i] = d_in[i];
    a.out = (float*)d_out; a.ws = (unsigned char*)d_ws;
#if MK_PER_PHASE
    for (int p = 0; p < NPHASE; ++p) { a.ph_lo = p; a.ph_hi = p + 1; a.li = 0; hipLaunchKernelGGL(fwd_kernel, dim3(grid), dim3(NWAVES * 64), LDS_BYTES, stream, a); }
#elif defined(PROBE_SEGS)
    const int segs[][2] = {PROBE_SEGS};
    for (int i = 0; i < (int)(sizeof(segs) / sizeof(segs[0])); ++i) { a.ph_lo = segs[i][0]; a.ph_hi = segs[i][1]; a.li = i; hipLaunchKernelGGL(fwd_kernel, dim3(grid), dim3(NWAVES * 64), LDS_BYTES, stream, a); }
#else
    a.ph_lo = 0; a.ph_hi = NPHASE; a.li = 0;
    hipLaunchKernelGGL(fwd_kernel, dim3(grid), dim3(NWAVES * 64), LDS_BYTES, stream, a);
#endif
}
```
